# Optimizing an MI355X kernel written in HIP

```python
import math
import jax, jax.numpy as jnp
from jax import lax
import numpy as np

D_MODEL = 1024
BATCH = 4
SEQ = 8192
DEPTH = 1

ATTN_HEADS = 8
HEAD_DIM = 64
ATTN_QK_WIDTH = ATTN_HEADS * 2 * HEAD_DIM
ATTN_V_WIDTH = ATTN_HEADS * 2 * HEAD_DIM
ATTN_WIDTH = ATTN_V_WIDTH
CONV_WIDTH = D_MODEL
CONV_K = 3
N_BRANCHES = 2
NUM_BUCKETS = 32
MAX_DISTANCE = 128
Q_BLOCK = 128
DEEPNORM_ALPHA = (2.0 * DEPTH) ** 0.25
DEEPNORM_BETA = (8.0 * DEPTH) ** -0.25
LN_EPS = 1e-5
RMS_EPS = 1e-5
NEG_INF = -1e30
IN_WIDTHS = [ATTN_QK_WIDTH, ATTN_QK_WIDTH, ATTN_V_WIDTH, ATTN_WIDTH,
             CONV_WIDTH, CONV_WIDTH, CONV_WIDTH, CONV_WIDTH]
IN_SPLITS = [int(s) for s in np.cumsum(IN_WIDTHS)[:-1]]
IN_TOTAL = int(sum(IN_WIDTHS))

kernel_name = "hybrid_diffattn_shortconv_gated_merge"


def layer_norm(x, gain=None, bias=None):
    xf = x.astype(jnp.float32)
    mu = jnp.mean(xf, axis=-1, keepdims=True)
    var = jnp.mean(jnp.square(xf - mu), axis=-1, keepdims=True)
    y = (xf - mu) * lax.rsqrt(var + LN_EPS)
    if gain is not None:
        y = y * gain.astype(jnp.float32) + bias.astype(jnp.float32)
    return y.astype(x.dtype)


def t5_bucket(rel):
    n = jnp.maximum(-rel, 0)
    max_exact = NUM_BUCKETS // 2
    is_small = n < max_exact
    nf = jnp.maximum(n, 1).astype(jnp.float32)
    large = max_exact + (jnp.log(nf / max_exact) / math.log(MAX_DISTANCE / max_exact)
                         * (NUM_BUCKETS - max_exact)).astype(jnp.int32)
    large = jnp.minimum(large, NUM_BUCKETS - 1)
    return jnp.where(is_small, n, large)


def diff_attention(q, k, v, lam, rel_bias):
    b_, s_, _ = q.shape
    nb = s_ // Q_BLOCK
    q = q * (HEAD_DIM ** -0.5)
    q = q.reshape(b_, nb, Q_BLOCK, ATTN_HEADS, 2, HEAD_DIM).transpose(1, 0, 3, 4, 2, 5)
    k = k.reshape(b_, s_, ATTN_HEADS, 2, HEAD_DIM).transpose(0, 2, 3, 1, 4)
    v = v.reshape(b_, s_, ATTN_HEADS, 2 * HEAD_DIM).transpose(0, 2, 1, 3)
    qpos = jnp.arange(s_, dtype=jnp.int32).reshape(nb, Q_BLOCK)
    kpos = jnp.arange(s_, dtype=jnp.int32)

    def block(args):
        q_blk, qp = args
        rel = kpos[None, :] - qp[:, None]
        bias = rel_bias[t5_bucket(rel)].astype(jnp.float32).transpose(2, 0, 1)
        s = jnp.einsum('bhiqd,bhikd->bhiqk', q_blk, k).astype(jnp.float32)
        s = s + bias[None, :, None]
        s = jnp.where((rel <= 0)[None, None, None], s, NEG_INF)
        p = jax.nn.softmax(s, axis=-1)
        a = p[:, :, 0] - lam * p[:, :, 1]
        return jnp.einsum('bhqk,bhkd->bhqd', a.astype(v.dtype), v)

    o = lax.map(block, (q, qpos))
    return o.transpose(1, 0, 3, 2, 4).reshape(b_, s_, ATTN_HEADS, 2 * HEAD_DIM)


def short_conv(bg, cg, xin, conv_w):
    v = cg * xin
    vp = jnp.pad(v, ((0, 0), (CONV_K - 1, 0), (0, 0)))
    s_ = v.shape[1]
    conv = conv_w[0] * vp[:, 0:s_] + conv_w[1] * vp[:, 1:s_ + 1] + conv_w[2] * vp[:, 2:s_ + 2]
    return bg * conv


def hybrid_layer(x, mod, w_in, lq1, lk1, lq2, lk2, subln_gain, rel_bias, conv_w,
                 w_branch, w_gate, b_gate, w_out, ln_gain, ln_bias, lambda_init):
    shift, scale, gate = jnp.split(mod, 3, axis=-1)
    u = layer_norm(x) * (1.0 + scale[:, None]) + shift[:, None]
    proj = jnp.einsum('bsd,de->bse', u, w_in)
    q, k, v, z_a, bg, cg, xin, z_c = jnp.split(proj, IN_SPLITS, axis=-1)

    lam = (jnp.exp(jnp.sum(lq1.astype(jnp.float32) * lk1.astype(jnp.float32)))
           - jnp.exp(jnp.sum(lq2.astype(jnp.float32) * lk2.astype(jnp.float32)))
           + lambda_init)
    o = diff_attention(q, k, v, lam, rel_bias).astype(jnp.float32)
    o = o * lax.rsqrt(jnp.mean(jnp.square(o), axis=-1, keepdims=True) + RMS_EPS)
    o = (o * subln_gain.astype(jnp.float32) * (1.0 - lambda_init)).astype(x.dtype)
    y_attn = o.reshape(x.shape[0], x.shape[1], ATTN_WIDTH) * jax.nn.silu(z_a)

    y_conv = short_conv(bg, cg, xin, conv_w) * jax.nn.silu(z_c)

    g_a, g_c = jnp.split(jax.nn.sigmoid(jnp.einsum('bsd,de->bse', u, w_gate) + b_gate), 2, axis=-1)
    merged = (g_a * jnp.einsum('bse,ed->bsd', y_attn, w_branch[0])
              + g_c * jnp.einsum('bse,ed->bsd', y_conv, w_branch[1]))
    out = jnp.einsum('bsd,de->bse', merged, w_out)

    return layer_norm(DEEPNORM_ALPHA * x + (1.0 + gate[:, None]) * out, ln_gain, ln_bias)


def setup_inputs(seed: int = 0) -> dict:
    key = jax.random.key(seed)
    ks = jax.random.split(key, 24)
    f32 = jnp.float32
    d = D_MODEL
    x = jax.random.normal(ks[0], (BATCH, SEQ, d), f32)
    c = jax.random.normal(ks[1], (BATCH, d), f32)
    w_ada = jax.random.normal(ks[2], (DEPTH, d, 3 * d), f32) * (d ** -0.5) * 0.1
    b_ada = jax.random.normal(ks[3], (DEPTH, 3 * d), f32) * 0.02
    col_scale = [1.0, 1.0, DEEPNORM_BETA, 1.0, 1.0, 1.0, DEEPNORM_BETA, 1.0]
    pieces = [jax.random.normal(kk, (DEPTH, d, wdt), f32) * (d ** -0.5) * sc
              for kk, wdt, sc in zip(jax.random.split(ks[4], len(IN_WIDTHS)), IN_WIDTHS, col_scale)]
    w_in = jnp.concatenate(pieces, axis=-1)
    lambda_q1 = jax.random.normal(ks[5], (DEPTH, HEAD_DIM), f32) * 0.1
    lambda_k1 = jax.random.normal(ks[6], (DEPTH, HEAD_DIM), f32) * 0.1
    lambda_q2 = jax.random.normal(ks[7], (DEPTH, HEAD_DIM), f32) * 0.1
    lambda_k2 = jax.random.normal(ks[8], (DEPTH, HEAD_DIM), f32) * 0.1
    subln_gain = 1.0 + 0.02 * jax.random.normal(ks[9], (DEPTH, 2 * HEAD_DIM), f32)
    rel_bias = jax.random.normal(ks[10], (NUM_BUCKETS, ATTN_HEADS), f32) * 0.3
    conv_w = jax.random.normal(ks[11], (DEPTH, CONV_K, CONV_WIDTH), f32) * (CONV_K ** -0.5)
    w_branch = jax.random.normal(ks[12], (DEPTH, N_BRANCHES, ATTN_WIDTH, d), f32) * (ATTN_WIDTH ** -0.5) * DEEPNORM_BETA
    w_gate = jax.random.normal(ks[13], (DEPTH, d, N_BRANCHES * d), f32) * (d ** -0.5)
    b_gate = jax.random.normal(ks[14], (DEPTH, N_BRANCHES * d), f32) * 0.1
    w_out = jax.random.normal(ks[15], (DEPTH, d, d), f32) * (d ** -0.5) * DEEPNORM_BETA
    ln_gain = 1.0 + 0.02 * jax.random.normal(ks[16], (DEPTH, d), f32)
    ln_bias = 0.02 * jax.random.normal(ks[17], (DEPTH, d), f32)
    return {"x": x, "c": c, "w_ada": w_ada, "b_ada": b_ada, "w_in": w_in,
            "lambda_q1": lambda_q1, "lambda_k1": lambda_k1, "lambda_q2": lambda_q2, "lambda_k2": lambda_k2,
            "subln_gain": subln_gain, "rel_bias": rel_bias, "conv_w": conv_w, "w_branch": w_branch,
            "w_gate": w_gate, "b_gate": b_gate, "w_out": w_out, "ln_gain": ln_gain, "ln_bias": ln_bias}


def reference(x, c, w_ada, b_ada, w_in, lambda_q1, lambda_k1, lambda_q2, lambda_k2,
              subln_gain, rel_bias, conv_w, w_branch, w_gate, b_gate, w_out, ln_gain, ln_bias):
    h = x
    for l in range(DEPTH):
        lambda_init = 0.8 - 0.6 * math.exp(-0.3 * l)
        mod = jnp.einsum('bd,de->be', c, w_ada[l]) + b_ada[l]
        h = hybrid_layer(h, mod, w_in[l], lambda_q1[l], lambda_k1[l], lambda_q2[l], lambda_k2[l],
                         subln_gain[l], rel_bias, conv_w[l], w_branch[l], w_gate[l], b_gate[l],
                         w_out[l], ln_gain[l], ln_bias[l], lambda_init)
    return h
```

```cpp
#ifndef DIAG
#define DIAG 0
#endif
#include <hip/hip_runtime.h>
#include <hip/hip_bf16.h>
#include <cstdio>
#include <cstdint>
#include <cmath>
namespace pg8 {
#define PG8_LAS __attribute__((address_space(3)))
typedef unsigned short bf16_t;
typedef short bf16x8 __attribute__((ext_vector_type(8)));
typedef float f32x4 __attribute__((ext_vector_type(4)));
typedef float f32x2 __attribute__((ext_vector_type(2)));
typedef unsigned u32x4 __attribute__((ext_vector_type(4)));
typedef unsigned u32x2 __attribute__((ext_vector_type(2)));
constexpr int BM = 256, BK = 64, HALF = 128, HTB = HALF * BK * 2  , STAGE_BYTES = 8 * HTB, NXCD = 8, WGM = 8;

__host__ __device__ __forceinline__ int lds_byte(int r, int c) { const int st = (r >> 4) * 2 + (c >> 5), rr = r & 15, cc = c & 31, ob = rr * 64 + cc * 2; return st * 1024 + (ob ^ (((ob >> 9) & 1) << 5)); }
__host__ __device__ __forceinline__ void stage_rc(int b, int& R, int& C) { const int st = b / 1024, sb = b % 1024, swz = sb ^ (((sb >> 9) & 1) << 5); R = (st >> 1) * 16 + swz / 64; C = (st & 1) * 32 + (swz % 64) / 2; }
__host__ __device__ __forceinline__ int perm32(int rho) { const int n = rho >> 4, i = rho & 15; return 8 * (i >> 2) + 4 * n + (i & 3); }

struct Unit { int pm, pn, half; };
struct Gemm { const bf16_t* A; const bf16_t* Bt; const bf16_t* A2; const bf16_t* Bt2; int M, N, K; };

struct StaticOrder {
    int nM, nN, nwg, G, c;
    __host__ __device__ void init(int M, int N, int G_, int c_) { nM = M / BM; nN = N / BM; nwg = nM * nN; G = G_; c = c_; }
    __host__ __device__ bool next(int i, Unit& u) const {
        const long L = (long)i * G + c; if (L >= nwg) return false;
        int wgid = (int)L; { const int q = nwg / NXCD, r = nwg % NXCD, xcd = wgid % NXCD, off = wgid / NXCD; wgid = (xcd < r ? xcd * (q + 1) : r * (q + 1) + (xcd - r) * q) + off; }
        const int nig = WGM * nN, gid = wgid / nig, fm = gid * WGM, gsz = (nM - fm) < WGM ? (nM - fm) : WGM;
        u.pm = fm + ((wgid % nig) % gsz); u.pn = (wgid % nig) / gsz; u.half = 0; return true;
    }
};
struct DualOrder {
    StaticOrder base;
    __host__ __device__ bool next(int j, Unit& u) const { if (!base.next(j >> 1, u)) return false; u.half = j & 1; return true; }
};

typedef __bf16 bf16x2_t __attribute__((ext_vector_type(2)));
__device__ __forceinline__ unsigned cvt_pk_bf16(float lo, float hi) { f32x2 v = {lo, hi}; bf16x2_t b = __builtin_convertvector(v, bf16x2_t); return __builtin_bit_cast(unsigned, b); }
__device__ __forceinline__ float bf_lo(unsigned w) { return __uint_as_float(w << 16); }
__device__ __forceinline__ float bf_hi(unsigned w) { return __uint_as_float(w & 0xffff0000u); }
__device__ __forceinline__ float sigmoid_f(float v) { return __builtin_amdgcn_rcpf(1.0f + __builtin_amdgcn_exp2f(v * -1.4426950408889634f)); }
__device__ __forceinline__ float silu_f(float v) { return v * sigmoid_f(v); }

constexpr float QSCALE = 0.125f * 1.4426950408889634f;

struct EpiProj {
    static constexpr bool PERM = true, AFTER_DRAIN = false;
    bf16_t* qkvz; size_t split_stride;
    bf16_t* Wc; bf16_t* Gc;
    __device__ __forceinline__ void operator()(const f32x4 (&acc)[2][2][4][2], const Unit& u, int wr, int wc, int fr, int fq) const {
        const int row0 = u.pm * BM + wr * 64 + fr; const int pn = u.pn;
        if (pn < 16) {
            const int t = pn >> 2; bf16_t* base = qkvz + (size_t)t * split_stride; const int col0 = (pn & 3) * BM + wc * 32 + 8 * fq;
#pragma unroll
            for (int ai = 0; ai < 2; ++ai)
#pragma unroll
                for (int m = 0; m < 4; ++m) { bf16_t* rowp = base + (size_t)(row0 + ai * HALF + m * 16) * 1024 + col0;
#pragma unroll
                    for (int bj = 0; bj < 2; ++bj) { f32x4 v0 = acc[ai][bj][m][0], v1 = acc[ai][bj][m][1];
                        if (t == 0) { v0 = v0 * QSCALE; v1 = v1 * QSCALE; }
                        if (t == 3) { v0 = (f32x4){silu_f(v0[0]), silu_f(v0[1]), silu_f(v0[2]), silu_f(v0[3])}; v1 = (f32x4){silu_f(v1[0]), silu_f(v1[1]), silu_f(v1[2]), silu_f(v1[3])}; }
                        u32x4 w; w.x = cvt_pk_bf16(v0[0], v0[1]); w.y = cvt_pk_bf16(v0[2], v0[3]); w.z = cvt_pk_bf16(v1[0], v1[1]); w.w = cvt_pk_bf16(v1[2], v1[3]);
                        *(u32x4*)(rowp + bj * HALF) = w; } }
        } else {
            const int ch0 = (pn - 16) * 64 + 4 * (4 * wc + fq);
#pragma unroll
            for (int ai = 0; ai < 2; ++ai)
#pragma unroll
                for (int m = 0; m < 4; ++m) { const size_t off = (size_t)(row0 + ai * HALF + m * 16) * 1024 + ch0;
                    const f32x4 bg = acc[ai][0][m][0], cg = acc[ai][0][m][1], xi = acc[ai][1][m][0], zc = acc[ai][1][m][1];
                    const f32x4 wv = cg * xi; const f32x4 gv = (f32x4){bg[0] * silu_f(zc[0]), bg[1] * silu_f(zc[1]), bg[2] * silu_f(zc[2]), bg[3] * silu_f(zc[3])};
                    u32x2 a, b; a.x = cvt_pk_bf16(wv[0], wv[1]); a.y = cvt_pk_bf16(wv[2], wv[3]); b.x = cvt_pk_bf16(gv[0], gv[1]); b.y = cvt_pk_bf16(gv[2], gv[3]);
                    *(u32x2*)(Wc + off) = a; *(u32x2*)(Gc + off) = b; }
        }
    }
    __device__ __forceinline__ void mid(f32x4 (&)[2][2][4][2], const Unit&, int, int, int, int) const {}
};


struct EpiGate {
    static constexpr bool PERM = true, AFTER_DRAIN = false;
    bf16_t* gate; const float* b_gate;
    __device__ __forceinline__ void operator()(const f32x4 (&acc)[2][2][4][2], const Unit& u, int wr, int wc, int fr, int fq) const {
        const int row0 = u.pm * BM + wr * 64 + fr; const int gc0 = u.pn * BM + wc * 32 + 8 * fq;
        f32x4 bv[2][2];
#pragma unroll
        for (int bj = 0; bj < 2; ++bj)
#pragma unroll
            for (int n = 0; n < 2; ++n) bv[bj][n] = *(const f32x4*)(b_gate + gc0 + bj * HALF + 4 * n);
#pragma unroll
        for (int ai = 0; ai < 2; ++ai)
#pragma unroll
            for (int m = 0; m < 4; ++m) { bf16_t* rowp = gate + (size_t)(row0 + ai * HALF + m * 16) * 2048 + gc0;
#pragma unroll
                for (int bj = 0; bj < 2; ++bj) { const f32x4 v0 = acc[ai][bj][m][0] + bv[bj][0], v1 = acc[ai][bj][m][1] + bv[bj][1];
                    u32x4 w; w.x = cvt_pk_bf16(sigmoid_f(v0[0]), sigmoid_f(v0[1])); w.y = cvt_pk_bf16(sigmoid_f(v0[2]), sigmoid_f(v0[3]));
                    w.z = cvt_pk_bf16(sigmoid_f(v1[0]), sigmoid_f(v1[1])); w.w = cvt_pk_bf16(sigmoid_f(v1[2]), sigmoid_f(v1[3]));
                    *(u32x4*)(rowp + bj * HALF) = w; } }
    }
    __device__ __forceinline__ void mid(f32x4 (&)[2][2][4][2], const Unit&, int, int, int, int) const {}
};

struct EpiMerged {
    static constexpr bool PERM = true, AFTER_DRAIN = false;
    const bf16_t* gate; bf16_t* out;
    __device__ __forceinline__ void mid(f32x4 (&acc)[2][2][4][2], const Unit& u, int wr, int wc, int fr, int fq) const {
        const int row0 = u.pm * BM + wr * 64 + fr, col0 = u.pn * BM + wc * 32 + 8 * fq;
#pragma unroll
        for (int ai = 0; ai < 2; ++ai)
#pragma unroll
            for (int m = 0; m < 4; ++m) { const bf16_t* gp = gate + (size_t)(row0 + ai * HALF + m * 16) * 2048 + col0;
#pragma unroll
                for (int bj = 0; bj < 2; ++bj) { const u32x4 a = *(const u32x4*)(gp + bj * HALF), c = *(const u32x4*)(gp + 1024 + bj * HALF);
                    f32x4 r0, r1;
                    r0[0] = bf_lo(a.x) / bf_lo(c.x); r0[1] = bf_hi(a.x) / bf_hi(c.x); r0[2] = bf_lo(a.y) / bf_lo(c.y); r0[3] = bf_hi(a.y) / bf_hi(c.y);
                    r1[0] = bf_lo(a.z) / bf_lo(c.z); r1[1] = bf_hi(a.z) / bf_hi(c.z); r1[2] = bf_lo(a.w) / bf_lo(c.w); r1[3] = bf_hi(a.w) / bf_hi(c.w);
                    acc[ai][bj][m][0] *= r0; acc[ai][bj][m][1] *= r1; } }
    }
    __device__ __forceinline__ void operator()(const f32x4 (&acc)[2][2][4][2], const Unit& u, int wr, int wc, int fr, int fq) const {
        const int row0 = u.pm * BM + wr * 64 + fr, col0 = u.pn * BM + wc * 32 + 8 * fq;
#pragma unroll
        for (int ai = 0; ai < 2; ++ai)
#pragma unroll
            for (int m = 0; m < 4; ++m) { const size_t r = (size_t)(row0 + ai * HALF + m * 16); const bf16_t* gp = gate + r * 2048 + 1024 + col0; bf16_t* op = out + r * 1024 + col0;
#pragma unroll
                for (int bj = 0; bj < 2; ++bj) { const u32x4 c = *(const u32x4*)(gp + bj * HALF); const f32x4 v0 = acc[ai][bj][m][0], v1 = acc[ai][bj][m][1];
                    u32x4 w; w.x = cvt_pk_bf16(v0[0] * bf_lo(c.x), v0[1] * bf_hi(c.x)); w.y = cvt_pk_bf16(v0[2] * bf_lo(c.y), v0[3] * bf_hi(c.y));
                    w.z = cvt_pk_bf16(v1[0] * bf_lo(c.z), v1[1] * bf_hi(c.z)); w.w = cvt_pk_bf16(v1[2] * bf_lo(c.w), v1[3] * bf_hi(c.w));
                    *(u32x4*)(op + bj * HALF) = w; } }
    }
};

struct EpiOut {
    static constexpr bool PERM = false, AFTER_DRAIN = false;
    const float* x; float* out; const float* modr;
    __device__ __forceinline__ void operator()(const f32x4 (&acc)[2][2][4][2], const Unit& u, int wr, int wc, int fr, int fq) const {
        const int row0 = u.pm * BM + wr * 64 + fr, col0 = u.pn * BM + wc * 32 + 4 * fq; const int b = u.pm >> 5;
        f32x4 g1[2][2];
#pragma unroll
        for (int bj = 0; bj < 2; ++bj)
#pragma unroll
            for (int n = 0; n < 2; ++n) g1[bj][n] = *(const f32x4*)(modr + b * 3072 + 2048 + col0 + bj * HALF + n * 16) + 1.0f;
#pragma unroll
        for (int ai = 0; ai < 2; ++ai)
#pragma unroll
            for (int m = 0; m < 4; ++m) { const size_t off = (size_t)(row0 + ai * HALF + m * 16) * 1024 + col0;
#pragma unroll
                for (int bj = 0; bj < 2; ++bj)
#pragma unroll
                    for (int n = 0; n < 2; ++n) { const f32x4 xv = *(const f32x4*)(x + off + bj * HALF + n * 16);
                        *(f32x4*)(out + off + bj * HALF + n * 16) = xv * 1.189207115002721f + g1[bj][n] * acc[ai][bj][m][n]; }
                if (m & 1) asm volatile("" ::: "memory"); }
    }
    __device__ __forceinline__ void mid(f32x4 (&)[2][2][4][2], const Unit&, int, int, int, int) const {}
};

template <class Epi, class Sched, bool ALIGN_EPI = false, bool SP2 = false, bool DUAL = false>
__device__ __forceinline__ void gemm_phase(PG8_LAS unsigned char* lds, const Gemm g, const Sched& S, const Epi& E) {
    const int tid = threadIdx.x, wid = __builtin_amdgcn_readfirstlane(tid >> 6), lane = tid & 63, wr = wid >> 2, wc = wid & 3, fr = lane & 15, fq = lane >> 4;
    const int K = g.K, nt = K / BK;
    unsigned voffA[2], voffB[2];
#pragma unroll
    for (int i = 0; i < 2; ++i) { int R, C; stage_rc(tid * 16 + i * 8192, R, C); const int Rb = Epi::PERM ? ((R & ~31) + perm32(R & 31)) : R;
        voffA[i] = (unsigned)(R * K + C) * 2u; voffB[i] = (unsigned)(Rb * K + C) * 2u; }
    const size_t kstep = (size_t)(BK * 2);
    const size_t hstep = (size_t)HALF * K * 2;
    const size_t tstep = 2 * hstep;
    const unsigned ldsw = (unsigned)wid * 1024u;
    const int aoff = lds_byte(wr * 64 + fr, fq * 8), boff = lds_byte(wc * 32 + fr, fq * 8);
#define PG8_SA(b, h) (((b) * 2 + (h)) * HTB)
#define PG8_SB(b, h) ((4 + (b) * 2 + (h)) * HTB)
#define PG8_STAGE(bufoff, gbase, voff) do { _Pragma("unroll") for (int _i = 0; _i < 2; ++_i) \
        __builtin_amdgcn_global_load_lds((const unsigned*)((const char*)(gbase) + (voff)[_i]), (PG8_LAS unsigned*)(lds + (bufoff) + ldsw + _i * 8192), 16, 0, 0); } while (0)
#define PG8_LDA(dst, b, h) do { _Pragma("unroll") for (int m = 0; m < 4; ++m) _Pragma("unroll") for (int k = 0; k < 2; ++k) dst[m][k] = *(const PG8_LAS bf16x8*)(lds + PG8_SA(b, h) + aoff + m * 2048 + k * 1024); } while (0)
#define PG8_LDB(dst, b, h) do { _Pragma("unroll") for (int n = 0; n < 2; ++n) _Pragma("unroll") for (int k = 0; k < 2; ++k) dst[n][k] = *(const PG8_LAS bf16x8*)(lds + PG8_SB(b, h) + boff + n * 2048 + k * 1024); } while (0)
#define PG8_MMA(ai, bj, At, Bt) do { __builtin_amdgcn_s_setprio(1); _Pragma("unroll") for (int m = 0; m < 4; ++m) _Pragma("unroll") for (int n = 0; n < 2; ++n) _Pragma("unroll") for (int k = 0; k < 2; ++k) \
        acc[ai][bj][m][n] = __builtin_amdgcn_mfma_f32_16x16x32_bf16(Bt[n][k], At[m][k], acc[ai][bj][m][n], 0, 0, 0); __builtin_amdgcn_s_setprio(0); } while (0)
#define PG8_WAIT_V(n) asm volatile("s_waitcnt vmcnt(" #n ")" ::: "memory")
#define PG8_WAIT_L(n) asm volatile("s_waitcnt lgkmcnt(" #n ")" ::: "memory")
#define PG8_BAR __builtin_amdgcn_s_barrier()
#define PG8_SCHED __builtin_amdgcn_sched_barrier(0)
    Unit cur, nxt; int ui = 0;
    if (!S.next(0, cur)) return;
    f32x4 acc[2][2][4][2];
#pragma unroll
    for (int a = 0; a < 2; ++a)
#pragma unroll
        for (int b = 0; b < 2; ++b)
#pragma unroll
            for (int m = 0; m < 4; ++m)
#pragma unroll
                for (int n = 0; n < 2; ++n) acc[a][b][m][n] = (f32x4){0.f, 0.f, 0.f, 0.f};
    bf16x8 At[4][2], B0[2][2], B1[2][2];
#define PG8_BASEA(u_) ((const char*)((DUAL && (u_).half) ? g.A2 : g.A) + (size_t)(u_).pm * tstep)
#define PG8_BASEB(u_) ((const char*)((DUAL && (u_).half) ? g.Bt2 : g.Bt) + (size_t)(u_).pn * tstep)
    const char* cA = PG8_BASEA(cur); const char* cB = PG8_BASEB(cur);
    if constexpr (SP2) {
        PG8_STAGE(PG8_SB(0, 0), cB, voffB); PG8_STAGE(PG8_SB(0, 1), cB + hstep, voffB); PG8_STAGE(PG8_SA(0, 0), cA, voffA); PG8_STAGE(PG8_SA(0, 1), cA + hstep, voffA);
        if (wr == 1) PG8_BAR;
        PG8_WAIT_V(2); PG8_BAR;
        PG8_STAGE(PG8_SB(1, 0), cB + kstep, voffB); PG8_STAGE(PG8_SA(1, 0), cA + kstep, voffA); PG8_STAGE(PG8_SB(1, 1), cB + hstep + kstep, voffB);
        PG8_WAIT_V(6); PG8_BAR;
    } else {
        PG8_STAGE(PG8_SB(0, 0), cB, voffB); PG8_STAGE(PG8_SA(0, 0), cA, voffA); PG8_STAGE(PG8_SB(0, 1), cB + hstep, voffB); PG8_STAGE(PG8_SA(0, 1), cA + hstep, voffA);
        if (wr == 1) PG8_BAR;
        PG8_WAIT_V(4); PG8_BAR;
        PG8_STAGE(PG8_SB(1, 0), cB + kstep, voffB); PG8_STAGE(PG8_SA(1, 0), cA + kstep, voffA); PG8_STAGE(PG8_SB(1, 1), cB + hstep + kstep, voffB);
        PG8_WAIT_V(6); PG8_BAR;
    }
    for (;;) {
        const bool has_next = S.next(ui + 1, nxt);
        const char* nA = has_next ? PG8_BASEA(nxt) : cA; const char* nB = has_next ? PG8_BASEB(nxt) : cB;
        for (int t = 0; t < nt; t += 2) {
            const bool last = (t == nt - 2);
            const char* a1 = cA + (size_t)(t + 1) * kstep;
            const char* a2 = last ? nA : cA + (size_t)(t + 2) * kstep; const char* b2 = last ? nB : cB + (size_t)(t + 2) * kstep;
            const char* a3 = a2 + kstep; const char* b3 = b2 + kstep;
            if constexpr (SP2) {
            PG8_LDB(B0, 0, 0); PG8_LDB(B1, 0, 1); PG8_SCHED; PG8_LDA(At, 0, 0); PG8_STAGE(PG8_SA(1, 1), a1 + hstep, voffA);
            PG8_WAIT_V(8); PG8_WAIT_L(0); PG8_BAR; PG8_MMA(0, 0, At, B0); PG8_MMA(0, 1, At, B1); PG8_BAR; PG8_SCHED;
            PG8_LDA(At, 0, 1); PG8_STAGE(PG8_SB(0, 0), b2, voffB); PG8_STAGE(PG8_SB(0, 1), b2 + hstep, voffB); PG8_STAGE(PG8_SA(0, 0), a2, voffA);
            PG8_WAIT_V(8); PG8_WAIT_L(0); PG8_BAR; PG8_MMA(1, 0, At, B0); PG8_MMA(1, 1, At, B1); PG8_BAR; PG8_SCHED;
            PG8_LDB(B0, 1, 0); PG8_LDB(B1, 1, 1); PG8_SCHED; PG8_LDA(At, 1, 0); PG8_STAGE(PG8_SA(0, 1), a2 + hstep, voffA);
            PG8_WAIT_V(8); PG8_WAIT_L(0); PG8_BAR; PG8_MMA(0, 0, At, B0); PG8_MMA(0, 1, At, B1); PG8_BAR; PG8_SCHED;
            PG8_LDA(At, 1, 1); PG8_STAGE(PG8_SB(1, 0), b3, voffB); PG8_STAGE(PG8_SB(1, 1), b3 + hstep, voffB); PG8_STAGE(PG8_SA(1, 0), a3, voffA);
            PG8_WAIT_V(8); PG8_WAIT_L(0); PG8_BAR; PG8_MMA(1, 0, At, B0); PG8_MMA(1, 1, At, B1); PG8_BAR; PG8_SCHED;
            } else {
            PG8_LDB(B0, 0, 0); PG8_SCHED; PG8_LDA(At, 0, 0); PG8_STAGE(PG8_SA(1, 1), a1 + hstep, voffA);
            PG8_WAIT_L(8); PG8_BAR; PG8_WAIT_L(0); PG8_MMA(0, 0, At, B0); PG8_BAR; PG8_SCHED;
            PG8_LDB(B1, 0, 1); PG8_STAGE(PG8_SB(0, 0), b2, voffB);
            PG8_BAR; PG8_WAIT_L(0); PG8_MMA(0, 1, At, B1); PG8_BAR;
            PG8_LDA(At, 0, 1); PG8_STAGE(PG8_SA(0, 0), a2, voffA);
            PG8_BAR; PG8_WAIT_L(0); PG8_MMA(1, 0, At, B0); PG8_BAR; PG8_SCHED;
            PG8_STAGE(PG8_SB(0, 1), b2 + hstep, voffB);
            PG8_WAIT_V(6); PG8_BAR; PG8_MMA(1, 1, At, B1); PG8_BAR;
            PG8_LDB(B0, 1, 0); PG8_SCHED; PG8_LDA(At, 1, 0); PG8_STAGE(PG8_SA(0, 1), a2 + hstep, voffA);
            PG8_WAIT_L(8); PG8_BAR; PG8_WAIT_L(0); PG8_MMA(0, 0, At, B0); PG8_BAR; PG8_SCHED;
            PG8_LDB(B1, 1, 1); PG8_STAGE(PG8_SB(1, 0), b3, voffB);
            PG8_BAR; PG8_WAIT_L(0); PG8_MMA(0, 1, At, B1); PG8_BAR;
            PG8_LDA(At, 1, 1); PG8_STAGE(PG8_SA(1, 0), a3, voffA);
            PG8_BAR; PG8_WAIT_L(0); PG8_MMA(1, 0, At, B0); PG8_BAR; PG8_SCHED;
            PG8_STAGE(PG8_SB(1, 1), b3 + hstep, voffB);
            PG8_WAIT_V(6); PG8_BAR; PG8_MMA(1, 1, At, B1); PG8_BAR;
            }
        }
        if constexpr (ALIGN_EPI) { if (wr == 0) PG8_BAR; }
        if constexpr (DUAL) { if (cur.half == 0) E.mid(acc, cur, wr, wc, fr, fq); else E(acc, cur, wr, wc, fr, fq); }
        else if constexpr (!Epi::AFTER_DRAIN) { E(acc, cur, wr, wc, fr, fq); }
        if (!has_next) break;
        if (!DUAL || cur.half == 1) {
#pragma unroll
        for (int a = 0; a < 2; ++a)
#pragma unroll
            for (int b = 0; b < 2; ++b)
#pragma unroll
                for (int m = 0; m < 4; ++m)
#pragma unroll
                    for (int n = 0; n < 2; ++n) acc[a][b][m][n] = (f32x4){0.f, 0.f, 0.f, 0.f};
        }
        cur = nxt; cA = nA; cB = nB; ++ui;
        if constexpr (ALIGN_EPI) { if (wr == 1) PG8_BAR; }
    }
    PG8_WAIT_V(0);
    if constexpr (!ALIGN_EPI) { if (wr == 0) PG8_BAR; }
    PG8_BAR;
    if constexpr (Epi::AFTER_DRAIN) { E.fused(acc, cur, wr, wc, fr, fq, lds, wid, lane); }
#undef PG8_BASEA
#undef PG8_BASEB
#undef PG8_SA
#undef PG8_SB
#undef PG8_STAGE
#undef PG8_LDA
#undef PG8_LDB
#undef PG8_MMA
#undef PG8_WAIT_V
#undef PG8_WAIT_L
#undef PG8_BAR
#undef PG8_SCHED
}
}

constexpr int NWAVES = 8;
#ifndef MK_N_LAUNCHES
#define MK_N_LAUNCHES 1
#endif
constexpr int N_LAUNCHES = MK_N_LAUNCHES;
#if MK_N_LAUNCHES == 1
#define LAUNCH_CUTS {0, 8}
#elif MK_N_LAUNCHES == 8
#define LAUNCH_CUTS {0, 1, 2, 3, 4, 5, 6, 7, 8}
#endif

constexpr int BATCH = 4, T = 8192, D = 1024;
constexpr int M = BATCH * T;
constexpr int NPROJ = 8192, NGATE = 2048;
constexpr float LN_EPS = 1e-5f, RMS_EPS = 1e-5f;

constexpr size_t MiB = 1u << 20;
constexpr size_t WS_CTL = 0, CTL_ZERO_BYTES = 128 * 1024;
constexpr size_t WS_MODP = 1 * MiB, WS_MODR = WS_MODP + 512 * 1024;
constexpr size_t WS_BT1 = 2 * MiB, WS_WB0 = 22 * MiB, WS_WB1 = 24 * MiB, WS_WO = 26 * MiB;
constexpr size_t WS_Q = 32 * MiB, WS_K = 96 * MiB, WS_V = 160 * MiB, WS_SZ = 224 * MiB;
constexpr size_t WS_WC = 288 * MiB, WS_GC = 352 * MiB, WS_U = 416 * MiB, WS_END = 480 * MiB;
static_assert(WS_K - WS_Q == WS_V - WS_K && WS_V - WS_K == WS_SZ - WS_V && (size_t)M * D * 2 == 64 * MiB, "d_ws map");
constexpr int CW_BAR = 1024;

constexpr int RING_OFF = 0, RING_BYTES = 131072;
constexpr int LDSCTL_OFF = RING_BYTES, MISC_OFF = LDSCTL_OFF + 320;
constexpr int LDS_BYTES = 147456;
static_assert(MISC_OFF + 128 <= LDS_BYTES, "LDS map");

#define GAS __attribute__((address_space(1)))
#define LAS __attribute__((address_space(3)))
typedef unsigned short bf16;
typedef unsigned v4u __attribute__((ext_vector_type(4)));
typedef float f32x4 __attribute__((ext_vector_type(4)));
typedef short bf16x8 __attribute__((ext_vector_type(8)));
typedef GAS unsigned gu32;
typedef GAS unsigned long long gu64;
#define RLX_AGENT __ATOMIC_RELAXED, __HIP_MEMORY_SCOPE_AGENT
#define LDS_WAIT() asm volatile("s_waitcnt lgkmcnt(0)" ::: "memory")
#define VM_WAIT() asm volatile("s_waitcnt vmcnt(0)" ::: "memory")
__device__ __forceinline__ unsigned long long rt() { return __builtin_amdgcn_s_memrealtime(); }
__device__ __forceinline__ unsigned f2bf(float f) { unsigned u = __builtin_bit_cast(unsigned, f); return (u + 0x7fffu + ((u >> 16) & 1u)) >> 16; }
__device__ __forceinline__ unsigned pk2(float lo, float hi) { return f2bf(lo) | (f2bf(hi) << 16); }

#define XB_TMO      128
#define XB_XCNT(j)  (256  + 64 * (j))
#define XB_XSUB(j)  (1280 + 64 * (j))
#define XB_XGEN(j)  (2304 + 64 * (j))
#define XB_TOP      3328
#define XB_TOPGEN   3392
#define XCD_BAR_WORDS 3456
#define XB_SPIN_CAP (1u << 18)

__device__ __forceinline__ unsigned xb_ld(unsigned* p)              { return __hip_atomic_load(p, __ATOMIC_RELAXED, __HIP_MEMORY_SCOPE_AGENT); }
__device__ __forceinline__ unsigned xb_add(unsigned* p, unsigned v) { return __hip_atomic_fetch_add(p, v, __ATOMIC_RELAXED, __HIP_MEMORY_SCOPE_AGENT); }
__device__ __forceinline__ unsigned xb_xcc_id() { return (unsigned)__builtin_amdgcn_s_getreg((3 << 11) | 20) & 0xFu; }
#define XB_SPIN(cond, bar) do { unsigned _sp = 0; while (cond) { __builtin_amdgcn_s_sleep(1); \
    if ((++_sp & 255u) == 0u) { if (xb_ld(&(bar)[XB_TMO])) break; if (_sp > XB_SPIN_CAP) { atomicAdd(&(bar)[XB_TMO], 1u); break; } } } } while (0)

struct XcdBarrier {
    unsigned* bar; unsigned x;
    volatile LAS unsigned* st;
};

__device__ __forceinline__ XcdBarrier xcd_barrier_post(unsigned* bar, volatile LAS unsigned* st) {
    XcdBarrier b; b.bar = bar; b.x = xb_xcc_id(); b.st = st;
    if (threadIdx.x == 0) (void)xb_add(&bar[XB_XCNT(b.x)], 1u);
    return b;
}
__device__ __forceinline__ void xcd_barrier_complete(unsigned* bar, unsigned x, unsigned& nloc, unsigned& nx) {
    const unsigned G = gridDim.x * gridDim.y * gridDim.z;
    unsigned sum, cnt, mine, sp = 0u;
    for (;;) {
        sum = 0u; cnt = 0u; mine = 0u;
#pragma unroll
        for (unsigned j = 0; j < 16; ++j) { const unsigned c = xb_ld(&bar[XB_XCNT(j)]); sum += c; cnt += (c > 0u) ? 1u : 0u; mine = (j == x) ? c : mine; }
        if (sum == G) break;
        __builtin_amdgcn_s_sleep(1);
        if ((++sp & 255u) == 0u) { if (xb_ld(&bar[XB_TMO])) break; if (sp > XB_SPIN_CAP) { atomicAdd(&bar[XB_TMO], 1u); break; } }
    }
    nloc = mine > 0u ? mine : 1u; nx = cnt > 0u ? cnt : 1u;
}

__device__ __forceinline__ void xcd_barrier(const XcdBarrier& b) {
    asm volatile("s_waitcnt vmcnt(0)" ::: "memory");
    __syncthreads();
    if (threadIdx.x == 0) {
        unsigned* bar = b.bar;
        __builtin_amdgcn_s_waitcnt(0);
        unsigned nloc = b.st[0], nx = b.st[1];
        if (nloc == 0u) { xcd_barrier_complete(bar, b.x, nloc, nx); b.st[0] = nloc; b.st[1] = nx; }
        const unsigned old = xb_add(&bar[XB_XSUB(b.x)], 1u);
        const unsigned gen = old / nloc;
        if (old + 1u == (gen + 1u) * nloc) {
            __builtin_amdgcn_fence(__ATOMIC_RELEASE, "agent");
            asm volatile("s_waitcnt vmcnt(0)" ::: "memory");
            const unsigned og = xb_add(&bar[XB_TOP], 1u);
            const unsigned tg = og / nx;
            if (og + 1u == (tg + 1u) * nx) xb_add(&bar[XB_TOPGEN], 1u);
            else XB_SPIN(xb_ld(&bar[XB_TOPGEN]) == tg, bar);
            __builtin_amdgcn_fence(__ATOMIC_ACQUIRE, "agent");
            xb_add(&bar[XB_XGEN(b.x)], 1u);
            asm volatile("s_waitcnt vmcnt(0)" ::: "memory");
        } else {
            XB_SPIN(xb_ld(&bar[XB_XGEN(b.x)]) == gen, bar);
            __builtin_amdgcn_fence(__ATOMIC_ACQUIRE, "agent");
            asm volatile("s_waitcnt vmcnt(0)" ::: "memory");
        }
    }
    __syncthreads();
}

struct Frame {
    LAS unsigned char* lds;
    volatile LAS unsigned* MISC;
    gu32* ctl;
    int tid, lane, wave;
    int vcu, G;
    const float *x, *c, *w_ada, *b_ada, *w_in, *lq1, *lk1, *lq2, *lk2, *subln, *rel_bias, *conv_w, *w_branch, *w_gate, *b_gate, *w_out, *ln_gain, *ln_bias;
    float* out;
    bf16 *Bt1, *WB0t, *WB1t, *WOt;
    bf16 *Qb, *Kb, *Vb, *SZ, *Wc, *Gc, *U, *YA, *GATE, *MRG;
    float *PRE;
    float *modp, *modr;
};

__device__ __forceinline__ float wave_sum(float v) {
#pragma unroll
    for (int o = 1; o < 64; o <<= 1) v += __shfl_xor(v, o);
    return v;
}
__device__ __forceinline__ int bt1_row(int s) {
    if (s < 4096) return s;
    const int kind = (s - 4096) >> 10, ch = s & 1023, ct = ch >> 6, cl = ch & 63;
    return 4096 + 256 * ct + 128 * (kind >> 1) + 8 * (cl >> 2) + 4 * (kind & 1) + (cl & 3);
}
template <bool PERMW>
__device__ __forceinline__ void p0_transpose_item(const float* W, int K, int N, bf16* WT, int row_off, LAS float* scr, int item, int lane) {
    const int nblk = N / 32, kb = item / nblk, nb = item % nblk, k0 = 64 * kb, n0 = 32 * nb;
#pragma unroll 8
    for (int i = 0; i < 32; ++i) { const int kk = 2 * i + (lane >> 5); scr[kk * 33 + (lane & 31)] = W[(size_t)(k0 + kk) * N + n0 + (lane & 31)]; }
    LDS_WAIT(); asm volatile("" ::: "memory");
    const int c = lane & 7;
#pragma unroll
    for (int j = 0; j < 4; ++j) { const int n = (lane >> 3) + 8 * j; const LAS float* s = scr + (8 * c) * 33 + n;
        v4u o; o.x = pk2(s[0 * 33], s[1 * 33]); o.y = pk2(s[2 * 33], s[3 * 33]); o.z = pk2(s[4 * 33], s[5 * 33]); o.w = pk2(s[6 * 33], s[7 * 33]);
        const int drow = PERMW ? bt1_row(n0 + n) : (row_off + n0 + n);
        *(GAS v4u*)(WT + (size_t)drow * K + k0 + 8 * c) = o; }
    LDS_WAIT(); asm volatile("" ::: "memory");
}
__device__ __forceinline__ void p0_mod_item(Frame& F, LAS float* scr, int item) {
    const int cg = item % 48, kc = item / 48, col = cg * 64 + F.lane, k0 = kc * 128;
#pragma unroll
    for (int i = 0; i < 8; ++i) { const int e = i * 64 + F.lane; scr[e] = F.c[(e >> 7) * D + k0 + (e & 127)]; }
    LDS_WAIT(); asm volatile("" ::: "memory");
    float a0 = 0.f, a1 = 0.f, a2 = 0.f, a3 = 0.f;
    const float* wp = F.w_ada + (size_t)k0 * 3072 + col;
#pragma unroll 8
    for (int k = 0; k < 128; ++k) { const float w = wp[(size_t)k * 3072]; a0 += scr[k] * w; a1 += scr[128 + k] * w; a2 += scr[256 + k] * w; a3 += scr[384 + k] * w; }
    float* mp = F.modp + (size_t)kc * 4 * 3072 + col;
    mp[0] = a0; mp[3072] = a1; mp[2 * 3072] = a2; mp[3 * 3072] = a3;
    LDS_WAIT(); asm volatile("" ::: "memory");
}
__device__ __forceinline__ void p0_prologue(Frame& F) {
    LAS float* scr = (LAS float*)(F.lds + RING_OFF + F.wave * 16384);
    const int gw = F.vcu * NWAVES + F.wave, NGW = F.G * NWAVES;
    constexpr int I_MOD = 48 * 8, I_IN = (D / 64) * (8192 / 32), I_G = (D / 64) * (2048 / 32), I_B = (D / 64) * (D / 32);
    constexpr int NITEMS = I_MOD + I_IN + I_G + 3 * I_B;
    for (int it = gw; it < NITEMS; it += NGW) {
        int r = it;
        if (r < I_MOD) { p0_mod_item(F, scr, r); continue; } r -= I_MOD;
        if (r < I_IN) { p0_transpose_item<true>(F.w_in, D, 8192, F.Bt1, 0, scr, r, F.lane); continue; } r -= I_IN;
        if (r < I_G) { p0_transpose_item<false>(F.w_gate, D, 2048, F.Bt1, 8192, scr, r, F.lane); continue; } r -= I_G;
        if (r < I_B) { p0_transpose_item<false>(F.w_branch, D, D, F.WB0t, 0, scr, r, F.lane); continue; } r -= I_B;
        if (r < I_B) { p0_transpose_item<false>(F.w_branch + (size_t)D * D, D, D, F.WB1t, 0, scr, r, F.lane); continue; } r -= I_B;
        p0_transpose_item<false>(F.w_out, D, D, F.WOt, 0, scr, r, F.lane);
    }
}
__device__ __forceinline__ void p0b_adaln(Frame& F) {
    LAS float* ms = (LAS float*)(F.lds + RING_OFF);
    const int j = F.vcu, b = j >> 6;
    for (int e = F.tid; e < 3072; e += NWAVES * 64) { float s = F.b_ada[e];
#pragma unroll
        for (int kc = 0; kc < 8; ++kc) s += F.modp[(size_t)(kc * 4 + b) * 3072 + e];
        ms[e] = s; if ((j & 63) == 0) F.modr[b * 3072 + e] = s; }
    __syncthreads();
    for (int rr = F.wave; rr < 128; rr += NWAVES) {
        const size_t m = (size_t)j * 128 + rr;
        const GAS f32x4* xr = (const GAS f32x4*)(F.x + m * D) + F.lane;
        f32x4 v[4]; float s = 0.f;
#pragma unroll
        for (int q = 0; q < 4; ++q) { v[q] = xr[64 * q]; s += (v[q].x + v[q].y) + (v[q].z + v[q].w); }
        const float mean = wave_sum(s) * (1.f / D); float s2 = 0.f;
#pragma unroll
        for (int q = 0; q < 4; ++q) { v[q] = v[q] - mean; s2 += (v[q].x * v[q].x + v[q].y * v[q].y) + (v[q].z * v[q].z + v[q].w * v[q].w); }
        const float rstd = 1.f / sqrtf(wave_sum(s2) * (1.f / D) + LN_EPS);
        GAS unsigned long long* o8 = (GAS unsigned long long*)(F.U + m * D) + F.lane;
#pragma unroll
        for (int q = 0; q < 4; ++q) { const int col = 256 * q + 4 * F.lane; const f32x4 sh = *(const LAS f32x4*)(ms + col), sc = *(const LAS f32x4*)(ms + 1024 + col);
            const f32x4 y = v[q] * rstd * (sc + 1.0f) + sh;
            o8[64 * q] = (unsigned long long)pk2(y.x, y.y) | ((unsigned long long)pk2(y.z, y.w) << 32); }
    }
}
__device__ __forceinline__ void p5_final_ln(Frame& F) {
    const int gw = F.vcu * NWAVES + F.wave, NGW = F.G * NWAVES;
    f32x4 gn[4], bs[4];
#pragma unroll
    for (int q = 0; q < 4; ++q) { gn[q] = *((const GAS f32x4*)F.ln_gain + F.lane + 64 * q); bs[q] = *((const GAS f32x4*)F.ln_bias + F.lane + 64 * q); }
    for (int m = gw; m < M; m += NGW) {
        const GAS f32x4* xr = (const GAS f32x4*)(F.PRE + (size_t)m * D) + F.lane; GAS f32x4* orow = (GAS f32x4*)(F.out + (size_t)m * D) + F.lane;
        f32x4 v[4]; float s = 0.f;
#pragma unroll
        for (int q = 0; q < 4; ++q) { v[q] = xr[64 * q]; s += (v[q].x + v[q].y) + (v[q].z + v[q].w); }
        const float mean = wave_sum(s) * (1.f / D); float s2 = 0.f;
#pragma unroll
        for (int q = 0; q < 4; ++q) { v[q] = v[q] - mean; s2 += (v[q].x * v[q].x + v[q].y * v[q].y) + (v[q].z * v[q].z + v[q].w * v[q].w); }
        const float rstd = 1.f / sqrtf(wave_sum(s2) * (1.f / D) + LN_EPS);
#pragma unroll
        for (int q = 0; q < 4; ++q) orow[64 * q] = v[q] * rstd * gn[q] + bs[q];
    }
}
__device__ __forceinline__ void p2_conv(Frame& F) {
    const size_t gt = (size_t)F.vcu * (NWAVES * 64) + F.tid, NT_ = (size_t)F.G * NWAVES * 64;
    for (size_t it = gt; it < (size_t)M * 128; it += NT_) {
        const size_t m = it >> 7; const int ch = (int)(it & 127) * 8, t = (int)(m & (T - 1));
        const v4u z4 = {0u, 0u, 0u, 0u};
        const v4u w2 = *(const GAS v4u*)(F.Wc + m * D + ch);
        const v4u w1 = t >= 1 ? *(const GAS v4u*)(F.Wc + (m - 1) * D + ch) : z4;
        const v4u w0 = t >= 2 ? *(const GAS v4u*)(F.Wc + (m - 2) * D + ch) : z4;
        const v4u g = *(const GAS v4u*)(F.Gc + m * D + ch);
        const f32x4 c0a = *(const GAS f32x4*)(F.conv_w + ch), c0b = *(const GAS f32x4*)(F.conv_w + ch + 4);
        const f32x4 c1a = *(const GAS f32x4*)(F.conv_w + D + ch), c1b = *(const GAS f32x4*)(F.conv_w + D + ch + 4);
        const f32x4 c2a = *(const GAS f32x4*)(F.conv_w + 2 * D + ch), c2b = *(const GAS f32x4*)(F.conv_w + 2 * D + ch + 4);
#define CV(e, W0, W1, W2, GG, LOHI, CA, CB, CC, idx) (LOHI(GG) * (CA[idx] * LOHI(W0) + CB[idx] * LOHI(W1) + CC[idx] * LOHI(W2)))
        v4u o;
        o.x = pk2(CV(0, w0.x, w1.x, w2.x, g.x, pg8::bf_lo, c0a, c1a, c2a, 0), CV(1, w0.x, w1.x, w2.x, g.x, pg8::bf_hi, c0a, c1a, c2a, 1));
        o.y = pk2(CV(2, w0.y, w1.y, w2.y, g.y, pg8::bf_lo, c0a, c1a, c2a, 2), CV(3, w0.y, w1.y, w2.y, g.y, pg8::bf_hi, c0a, c1a, c2a, 3));
        o.z = pk2(CV(4, w0.z, w1.z, w2.z, g.z, pg8::bf_lo, c0b, c1b, c2b, 0), CV(5, w0.z, w1.z, w2.z, g.z, pg8::bf_hi, c0b, c1b, c2b, 1));
        o.w = pk2(CV(6, w0.w, w1.w, w2.w, g.w, pg8::bf_lo, c0b, c1b, c2b, 2), CV(7, w0.w, w1.w, w2.w, g.w, pg8::bf_hi, c0b, c1b, c2b, 3));
#undef CV
        *(GAS v4u*)(F.Gc + m * D + ch) = o;
    }
}
__device__ __forceinline__ int t5_bucket(int n) {
    if (n < 16) return n;
    const int lg = 16 + (int)(__logf((float)n * (1.0f / 16.0f)) * (16.0f / 2.0794415416798357f));
    return lg < 31 ? lg : 31;
}
__device__ __forceinline__ float diff_lambda(Frame& F) {
    float s1 = 0.f, s2 = 0.f;
    for (int d = 0; d < 64; ++d) { s1 += F.lq1[d] * F.lk1[d]; s2 += F.lq2[d] * F.lk2[d]; }
    return expf(s1) - expf(s2) + 0.2f;
}

__device__ __forceinline__ void p2_attn_naive(Frame& F) {
    LAS unsigned char* Kt = F.lds + RING_OFF;
    LAS unsigned char* Vt = Kt + 16384;
    LAS float* O1 = (LAS float*)(Kt + 32768);
    LAS float* tbl = (LAS float*)(Kt + 32768 + 128 * 129 * 4);
    LAS float* SSQ = tbl + 128;
    const int tid = F.tid, row = tid & 127, map = __builtin_amdgcn_readfirstlane((tid >> 7) & 1), half = __builtin_amdgcn_readfirstlane(tid >> 8);
    const float lam = diff_lambda(F);
    for (int i = 0; i < 8; ++i) {
        const int bh = F.vcu >> 3, s = F.vcu & 7, qb = (i & 1) ? (16 * (i >> 1) + 15 - s) : (16 * (i >> 1) + s), b = bh >> 3, h = bh & 7;
        __syncthreads();
        if (tid < 128) tbl[tid] = F.rel_bias[t5_bucket(tid) * 8 + h] * 1.4426950408889634f;
        const int qpos = qb * 128 + row; const size_t rowg = (size_t)b * T + qpos;
        float q[64], o[64];
        { const GAS v4u* qp = (const GAS v4u*)(F.Qb + rowg * D + h * 128 + map * 64);
#pragma unroll
          for (int c8 = 0; c8 < 8; ++c8) { const v4u w = qp[c8]; q[c8 * 8 + 0] = pg8::bf_lo(w.x); q[c8 * 8 + 1] = pg8::bf_hi(w.x); q[c8 * 8 + 2] = pg8::bf_lo(w.y); q[c8 * 8 + 3] = pg8::bf_hi(w.y);
              q[c8 * 8 + 4] = pg8::bf_lo(w.z); q[c8 * 8 + 5] = pg8::bf_hi(w.z); q[c8 * 8 + 6] = pg8::bf_lo(w.w); q[c8 * 8 + 7] = pg8::bf_hi(w.w); } }
#pragma unroll
        for (int d = 0; d < 64; ++d) o[d] = 0.f;
        float mx = -1e30f, l = 0.f;
        const int ntile = (qb * 128 + 128) / 64;
        for (int t = 0; t < ntile; ++t) {
            __syncthreads();
            for (int c = tid; c < 1024; c += NWAVES * 64) { const int r = c >> 4, ch = c & 15; const size_t g = ((size_t)b * T + t * 64 + r) * D + h * 128 + ch * 8;
                *(LAS v4u*)(Kt + r * 256 + ch * 16) = *(const GAS v4u*)(F.Kb + g); *(LAS v4u*)(Vt + r * 256 + ch * 16) = *(const GAS v4u*)(F.Vb + g); }
            __syncthreads();
            const int kmax = qpos - t * 64 + 1;
            for (int jk = 0; jk < 64; ++jk) {
                if (jk < kmax) {
                    float sc = 0.f;
#pragma unroll
                    for (int c8 = 0; c8 < 8; ++c8) { const v4u w = *(const LAS v4u*)(Kt + jk * 256 + map * 128 + c8 * 16);
                        sc += q[c8 * 8 + 0] * pg8::bf_lo(w.x) + q[c8 * 8 + 1] * pg8::bf_hi(w.x) + q[c8 * 8 + 2] * pg8::bf_lo(w.y) + q[c8 * 8 + 3] * pg8::bf_hi(w.y)
                            + q[c8 * 8 + 4] * pg8::bf_lo(w.z) + q[c8 * 8 + 5] * pg8::bf_hi(w.z) + q[c8 * 8 + 6] * pg8::bf_lo(w.w) + q[c8 * 8 + 7] * pg8::bf_hi(w.w); }
                    const int dist = qpos - (t * 64 + jk);
                    sc += tbl[dist < 127 ? dist : 127];
                    if (sc > mx) { const float f = __builtin_amdgcn_exp2f(mx - sc); l *= f;
#pragma unroll
                        for (int d = 0; d < 64; ++d) o[d] *= f;
                        mx = sc; }
                    const float p = __builtin_amdgcn_exp2f(sc - mx); l += p;
#pragma unroll
                    for (int c8 = 0; c8 < 8; ++c8) { const v4u w = *(const LAS v4u*)(Vt + jk * 256 + half * 128 + c8 * 16);
                        o[c8 * 8 + 0] += p * pg8::bf_lo(w.x); o[c8 * 8 + 1] += p * pg8::bf_hi(w.x); o[c8 * 8 + 2] += p * pg8::bf_lo(w.y); o[c8 * 8 + 3] += p * pg8::bf_hi(w.y);
                        o[c8 * 8 + 4] += p * pg8::bf_lo(w.z); o[c8 * 8 + 5] += p * pg8::bf_hi(w.z); o[c8 * 8 + 6] += p * pg8::bf_lo(w.w); o[c8 * 8 + 7] += p * pg8::bf_hi(w.w); }
                }
            }
        }
        const float il = 1.0f / l;
        if (map == 1) {
#pragma unroll
            for (int d = 0; d < 64; ++d) O1[row * 129 + half * 64 + d] = o[d] * il; }
        __syncthreads();
        if (map == 0) { float ss = 0.f;
#pragma unroll
            for (int d = 0; d < 64; ++d) { o[d] = o[d] * il - lam * O1[row * 129 + half * 64 + d]; ss += o[d] * o[d]; }
            SSQ[row * 2 + half] = ss; }
        __syncthreads();
        if (map == 0) { const float rn = 1.0f / sqrtf((SSQ[row * 2] + SSQ[row * 2 + 1]) * (1.0f / 128.0f) + RMS_EPS) * 0.8f;
            const size_t ob = rowg * D + h * 128 + half * 64;
#pragma unroll
            for (int c8 = 0; c8 < 8; ++c8) { const v4u z = *(const GAS v4u*)(F.SZ + ob + c8 * 8); const f32x4 g0 = *(const GAS f32x4*)(F.subln + half * 64 + c8 * 8), g1 = *(const GAS f32x4*)(F.subln + half * 64 + c8 * 8 + 4);
                v4u w; w.x = pk2(o[c8 * 8 + 0] * rn * g0.x * pg8::bf_lo(z.x), o[c8 * 8 + 1] * rn * g0.y * pg8::bf_hi(z.x)); w.y = pk2(o[c8 * 8 + 2] * rn * g0.z * pg8::bf_lo(z.y), o[c8 * 8 + 3] * rn * g0.w * pg8::bf_hi(z.y));
                w.z = pk2(o[c8 * 8 + 4] * rn * g1.x * pg8::bf_lo(z.z), o[c8 * 8 + 5] * rn * g1.y * pg8::bf_hi(z.z)); w.w = pk2(o[c8 * 8 + 6] * rn * g1.z * pg8::bf_lo(z.w), o[c8 * 8 + 7] * rn * g1.w * pg8::bf_hi(z.w));
                *(GAS v4u*)(F.YA + ob + c8 * 8) = w; } }
    }
}

struct Args { const float* in[18]; float* out; unsigned char* ws; int ph_lo, ph_hi, li, pad; };
__global__ void __launch_bounds__(NWAVES * 64, 2) skel_fwd(Args args) {
    extern __shared__ __attribute__((aligned(16))) unsigned char lds[];
    Frame F;
    F.lds = (LAS unsigned char*)lds;
    F.MISC = (volatile LAS unsigned*)(F.lds + MISC_OFF);
    F.tid = threadIdx.x; F.lane = F.tid & 63; F.wave = __builtin_amdgcn_readfirstlane(F.tid >> 6);
    F.G = gridDim.x; { const int bx = blockIdx.x; F.vcu = (F.G % 8 == 0) ? (bx % 8) * (F.G / 8) + bx / 8 : bx; }
    unsigned char* ws = args.ws;
    F.ctl = (gu32*)(ws + WS_CTL);
    F.x = args.in[0]; F.c = args.in[1]; F.w_ada = args.in[2]; F.b_ada = args.in[3]; F.w_in = args.in[4]; F.lq1 = args.in[5]; F.lk1 = args.in[6]; F.lq2 = args.in[7]; F.lk2 = args.in[8];
    F.subln = args.in[9]; F.rel_bias = args.in[10]; F.conv_w = args.in[11]; F.w_branch = args.in[12]; F.w_gate = args.in[13]; F.b_gate = args.in[14]; F.w_out = args.in[15];
    F.ln_gain = args.in[16]; F.ln_bias = args.in[17]; F.out = args.out;
    F.Bt1 = (bf16*)(ws + WS_BT1); F.WB0t = (bf16*)(ws + WS_WB0); F.WB1t = (bf16*)(ws + WS_WB1); F.WOt = (bf16*)(ws + WS_WO);
    F.Qb = (bf16*)(ws + WS_Q); F.Kb = (bf16*)(ws + WS_K); F.Vb = (bf16*)(ws + WS_V); F.SZ = (bf16*)(ws + WS_SZ); F.Wc = (bf16*)(ws + WS_WC); F.Gc = (bf16*)(ws + WS_GC);
    F.U = (bf16*)(ws + WS_U); F.YA = (bf16*)(ws + WS_Q); F.MRG = (bf16*)(ws + WS_SZ); F.GATE = (bf16*)(ws + WS_K); F.PRE = (float*)(ws + WS_K);
    F.modp = (float*)(ws + WS_MODP); F.modr = (float*)(ws + WS_MODR);
    for (int u = F.tid; u < (LDS_BYTES - LDSCTL_OFF) / 4; u += NWAVES * 64) ((LAS unsigned*)(F.lds + LDSCTL_OFF))[u] = 0u;
    __syncthreads();
    XcdBarrier bar = xcd_barrier_post((unsigned*)(F.ctl + CW_BAR) + args.li * XCD_BAR_WORDS, F.MISC + 8);
#define GRID_BAR() xcd_barrier(bar)
    const int lo = args.ph_lo, hi = args.ph_hi;
#define IN(k) (lo <= (k) && (k) < hi)
#define BOTH(k) (IN(k) && IN((k) + 1))

#if DIAG == 3
    { float* scrg = (float*)(ws + 480 * MiB); const size_t gt = (size_t)F.vcu * (NWAVES * 64) + F.tid, NT_ = (size_t)F.G * NWAVES * 64;
      for (size_t i = gt; i < (size_t)2 * 1024 * 1024; i += NT_) scrg[i] = F.w_gate[i]; }
#endif
    if (IN(0)) { p0_prologue(F); if (BOTH(0)) GRID_BAR(); }
    if (IN(1)) { p0b_adaln(F); if (BOTH(1)) GRID_BAR(); }
    if (IN(2)) {
        pg8::Gemm g{F.U, F.Bt1, nullptr, nullptr, M, NPROJ, D}; pg8::StaticOrder S; S.init(M, NPROJ, F.G, (int)blockIdx.x);
        pg8::EpiProj E{F.Qb, (size_t)(WS_K - WS_Q) / 2, F.Wc, F.Gc};
        pg8::gemm_phase<pg8::EpiProj, pg8::StaticOrder, true, true, false>(F.lds + RING_OFF, g, S, E);
        if (BOTH(2)) GRID_BAR();
    }
    if (IN(3)) {
        p2_conv(F);
        p2_attn_naive(F);
        if (BOTH(3)) GRID_BAR();
    }
    if (IN(4)) {
        pg8::Gemm g{F.U, F.Bt1 + (size_t)NPROJ * D, nullptr, nullptr, M, NGATE, D}; pg8::StaticOrder S; S.init(M, NGATE, F.G, (int)blockIdx.x);
        pg8::EpiGate E{F.GATE, F.b_gate};
        pg8::gemm_phase<pg8::EpiGate, pg8::StaticOrder, true, true, false>(F.lds + RING_OFF, g, S, E);
        if (BOTH(4)) GRID_BAR();
    }
    if (IN(5) && DIAG != 1 && DIAG < 3) {
        pg8::Gemm g{F.YA, F.WB0t, F.Gc, F.WB1t, M, D, D}; pg8::DualOrder S; S.base.init(M, D, F.G, (int)blockIdx.x);
        pg8::EpiMerged E{F.GATE, F.MRG};
        pg8::gemm_phase<pg8::EpiMerged, pg8::DualOrder, true, true, true>(F.lds + RING_OFF, g, S, E);
        if (BOTH(5)) GRID_BAR();
    }
    if (IN(6) && DIAG == 0) {
        pg8::Gemm g{F.MRG, F.WOt, nullptr, nullptr, M, D, D}; pg8::StaticOrder S; S.init(M, D, F.G, (int)blockIdx.x);
        pg8::EpiOut E{F.x, F.PRE, F.modr};
        pg8::gemm_phase<pg8::EpiOut, pg8::StaticOrder, true, true, false>(F.lds + RING_OFF, g, S, E);
        if (BOTH(6)) GRID_BAR();
    }
#if DIAG == 1
    if (IN(7)) { const size_t gt = (size_t)F.vcu * (NWAVES * 64) + F.tid, NT_ = (size_t)F.G * NWAVES * 64;
        for (size_t i = gt; i < (size_t)M * D; i += NT_) F.out[i] = __uint_as_float((unsigned)F.GATE[(i >> 10) * 2048 + (i & 1023)] << 16); }
#elif DIAG == 3
    if (IN(7)) { const float* scrg = (const float*)(ws + 480 * MiB); const size_t gt = (size_t)F.vcu * (NWAVES * 64) + F.tid, NT_ = (size_t)F.G * NWAVES * 64;
        for (size_t i = gt; i < (size_t)M * D; i += NT_) F.out[i] = scrg[i & (2 * 1024 * 1024 - 1)]; }
#elif DIAG == 4
    if (IN(7)) { const bf16* src = F.Bt1 + (size_t)NPROJ * D; const size_t gt = (size_t)F.vcu * (NWAVES * 64) + F.tid, NT_ = (size_t)F.G * NWAVES * 64;
        for (size_t i = gt; i < (size_t)M * D; i += NT_) F.out[i] = __uint_as_float((unsigned)src[i & (2 * 1024 * 1024 - 1)] << 16); }
#elif DIAG == 2
    if (IN(7)) { const size_t gt = (size_t)F.vcu * (NWAVES * 64) + F.tid, NT_ = (size_t)F.G * NWAVES * 64;
        for (size_t i = gt; i < (size_t)M * D; i += NT_) F.out[i] = __uint_as_float((unsigned)F.MRG[i] << 16); }
#else
    if (IN(7)) { p5_final_ln(F); }
#endif
#undef IN
#undef BOTH
}

extern "C" void kernel_launch(void* const* d_in, const int* in_sizes, int n_in, void* d_out, int out_size, void* d_ws, size_t ws_size, hipStream_t stream) {
    static int grid = 0;
    if (grid == 0) {
        if (n_in != 18 || in_sizes[0] != M * D || out_size != M * D || ws_size < WS_END) { fprintf(stderr, "kernel_launch: shape/workspace mismatch (n_in %d, in0 %d, out %d, ws %zu); nothing launched\n", n_in, n_in > 0 ? in_sizes[0] : -1, out_size, ws_size); grid = -1; return; }
        int dev = 0, cus = 0, per_cu = 0;
        if (hipGetDevice(&dev) != hipSuccess || hipDeviceGetAttribute(&cus, hipDeviceAttributeMultiprocessorCount, dev) != hipSuccess) { fprintf(stderr, "kernel_launch: hipGetDevice / hipDeviceGetAttribute failed\n"); grid = -1; return; }
        if (hipFuncSetAttribute((const void*)skel_fwd, hipFuncAttributeMaxDynamicSharedMemorySize, LDS_BYTES) != hipSuccess) { fprintf(stderr, "kernel_launch: hipFuncSetAttribute failed\n"); grid = -1; return; }
        if (hipOccupancyMaxActiveBlocksPerMultiprocessor(&per_cu, (const void*)skel_fwd, NWAVES * 64, LDS_BYTES) != hipSuccess || per_cu < 1)
            fprintf(stderr, "kernel_launch: note: the occupancy query reports %d workgroups per CU\n", per_cu);
        (void)hipGetLastError();
        grid = cus;
    }
    if (grid < 0) return;
    if (hipMemsetAsync((char*)d_ws + WS_CTL, 0, CTL_ZERO_BYTES, stream) != hipSuccess) { fprintf(stderr, "kernel_launch: hipMemsetAsync failed\n"); return; }
    Args a{};
    for (int i = 0; i < 18; ++i) a.in[i] = (const float*)d_in[i];
    a.out = (float*)d_out; a.ws = (unsigned char*)d_ws;
    const int NPH = 8;
    const int cuts[N_LAUNCHES + 1] = LAUNCH_CUTS;
    for (int li = 0; li < N_LAUNCHES; ++li) {
        a.ph_lo = cuts[li]; a.ph_hi = cuts[li + 1]; a.li = li; (void)NPH;
        hipLaunchKernelGGL(skel_fwd, dim3(grid), dim3(NWAVES * 64), LDS_BYTES, stream, a);
        const hipError_t le = hipPeekAtLastError();
        if (le != hipSuccess) { fprintf(stderr, "kernel_launch: launch %d failed: %s\n", li, hipGetErrorName(le)); break; }
    }
}
```

```cpp
#ifndef DIAG
#define DIAG 0
#endif
#include <hip/hip_runtime.h>
#include <hip/hip_bf16.h>
#include <cstdio>
#include <cstdint>
#include <cmath>
namespace pg8 {
#define PG8_LAS __attribute__((address_space(3)))
typedef unsigned short bf16_t;
typedef short bf16x8 __attribute__((ext_vector_type(8)));
typedef float f32x4 __attribute__((ext_vector_type(4)));
typedef float f32x2 __attribute__((ext_vector_type(2)));
typedef unsigned u32x4 __attribute__((ext_vector_type(4)));
typedef unsigned u32x2 __attribute__((ext_vector_type(2)));
constexpr int BM = 256, BK = 64, HALF = 128, HTB = HALF * BK * 2  , STAGE_BYTES = 8 * HTB, NXCD = 8, WGM = 8;

__host__ __device__ __forceinline__ int lds_byte(int r, int c) { const int st = (r >> 4) * 2 + (c >> 5), rr = r & 15, cc = c & 31, ob = rr * 64 + cc * 2; return st * 1024 + (ob ^ (((ob >> 9) & 1) << 5)); }
__host__ __device__ __forceinline__ void stage_rc(int b, int& R, int& C) { const int st = b / 1024, sb = b % 1024, swz = sb ^ (((sb >> 9) & 1) << 5); R = (st >> 1) * 16 + swz / 64; C = (st & 1) * 32 + (swz % 64) / 2; }
__host__ __device__ __forceinline__ int perm32(int rho) { const int n = rho >> 4, i = rho & 15; return 8 * (i >> 2) + 4 * n + (i & 3); }

struct Unit { int pm, pn, half; };
struct Gemm { const bf16_t* A; const bf16_t* Bt; const bf16_t* A2; const bf16_t* Bt2; int M, N, K; };

struct StaticOrder {
    int nM, nN, nwg, G, c;
    __host__ __device__ void init(int M, int N, int G_, int c_) { nM = M / BM; nN = N / BM; nwg = nM * nN; G = G_; c = c_; }
    __host__ __device__ bool next(int i, Unit& u) const {
        const long L = (long)i * G + c; if (L >= nwg) return false;
        int wgid = (int)L; { const int q = nwg / NXCD, r = nwg % NXCD, xcd = wgid % NXCD, off = wgid / NXCD; wgid = (xcd < r ? xcd * (q + 1) : r * (q + 1) + (xcd - r) * q) + off; }
        const int nig = WGM * nN, gid = wgid / nig, fm = gid * WGM, gsz = (nM - fm) < WGM ? (nM - fm) : WGM;
        u.pm = fm + ((wgid % nig) % gsz); u.pn = (wgid % nig) / gsz; u.half = 0; return true;
    }
};
struct DualOrder {
    StaticOrder base;
    __host__ __device__ bool next(int j, Unit& u) const { if (!base.next(j >> 1, u)) return false; u.half = j & 1; return true; }
};

typedef __bf16 bf16x2_t __attribute__((ext_vector_type(2)));
__device__ __forceinline__ unsigned cvt_pk_bf16(float lo, float hi) { f32x2 v = {lo, hi}; bf16x2_t b = __builtin_convertvector(v, bf16x2_t); return __builtin_bit_cast(unsigned, b); }
__device__ __forceinline__ float bf_lo(unsigned w) { return __uint_as_float(w << 16); }
__device__ __forceinline__ float bf_hi(unsigned w) { return __uint_as_float(w & 0xffff0000u); }
__device__ __forceinline__ float sigmoid_f(float v) { return __builtin_amdgcn_rcpf(1.0f + __builtin_amdgcn_exp2f(v * -1.4426950408889634f)); }
__device__ __forceinline__ float silu_f(float v) { return v * sigmoid_f(v); }

constexpr float QSCALE = 0.125f * 1.4426950408889634f;

struct EpiProj {
    static constexpr bool PERM = true, AFTER_DRAIN = false;
    bf16_t* qkvz; size_t split_stride;
    bf16_t* Wc; bf16_t* Gc;
    __device__ __forceinline__ void operator()(const f32x4 (&acc)[2][2][4][2], const Unit& u, int wr, int wc, int fr, int fq) const {
        const int row0 = u.pm * BM + wr * 64 + fr; const int pn = u.pn;
        if (pn < 16) {
            const int t = pn >> 2; bf16_t* base = qkvz + (size_t)t * split_stride; const int col0 = (pn & 3) * BM + wc * 32 + 8 * fq;
#pragma unroll
            for (int ai = 0; ai < 2; ++ai)
#pragma unroll
                for (int m = 0; m < 4; ++m) { bf16_t* rowp = base + (size_t)(row0 + ai * HALF + m * 16) * 1024 + col0;
#pragma unroll
                    for (int bj = 0; bj < 2; ++bj) { f32x4 v0 = acc[ai][bj][m][0], v1 = acc[ai][bj][m][1];
                        if (t == 0) { v0 = v0 * QSCALE; v1 = v1 * QSCALE; }
                        if (t == 3) { v0 = (f32x4){silu_f(v0[0]), silu_f(v0[1]), silu_f(v0[2]), silu_f(v0[3])}; v1 = (f32x4){silu_f(v1[0]), silu_f(v1[1]), silu_f(v1[2]), silu_f(v1[3])}; }
                        u32x4 w; w.x = cvt_pk_bf16(v0[0], v0[1]); w.y = cvt_pk_bf16(v0[2], v0[3]); w.z = cvt_pk_bf16(v1[0], v1[1]); w.w = cvt_pk_bf16(v1[2], v1[3]);
                        *(u32x4*)(rowp + bj * HALF) = w; } }
        } else {
            const int ch0 = (pn - 16) * 64 + 4 * (4 * wc + fq);
#pragma unroll
            for (int ai = 0; ai < 2; ++ai)
#pragma unroll
                for (int m = 0; m < 4; ++m) { const size_t off = (size_t)(row0 + ai * HALF + m * 16) * 1024 + ch0;
                    const f32x4 bg = acc[ai][0][m][0], cg = acc[ai][0][m][1], xi = acc[ai][1][m][0], zc = acc[ai][1][m][1];
                    const f32x4 wv = cg * xi; const f32x4 gv = (f32x4){bg[0] * silu_f(zc[0]), bg[1] * silu_f(zc[1]), bg[2] * silu_f(zc[2]), bg[3] * silu_f(zc[3])};
                    u32x2 a, b; a.x = cvt_pk_bf16(wv[0], wv[1]); a.y = cvt_pk_bf16(wv[2], wv[3]); b.x = cvt_pk_bf16(gv[0], gv[1]); b.y = cvt_pk_bf16(gv[2], gv[3]);
                    *(u32x2*)(Wc + off) = a; *(u32x2*)(Gc + off) = b; }
        }
    }
    __device__ __forceinline__ void mid(f32x4 (&)[2][2][4][2], const Unit&, int, int, int, int) const {}
};


struct EpiGate {
    static constexpr bool PERM = true, AFTER_DRAIN = false;
    bf16_t* gate; const float* b_gate;
    __device__ __forceinline__ void operator()(const f32x4 (&acc)[2][2][4][2], const Unit& u, int wr, int wc, int fr, int fq) const {
        const int row0 = u.pm * BM + wr * 64 + fr; const int gc0 = u.pn * BM + wc * 32 + 8 * fq;
        f32x4 bv[2][2];
#pragma unroll
        for (int bj = 0; bj < 2; ++bj)
#pragma unroll
            for (int n = 0; n < 2; ++n) bv[bj][n] = *(const f32x4*)(b_gate + gc0 + bj * HALF + 4 * n);
#pragma unroll
        for (int ai = 0; ai < 2; ++ai)
#pragma unroll
            for (int m = 0; m < 4; ++m) { bf16_t* rowp = gate + (size_t)(row0 + ai * HALF + m * 16) * 2048 + gc0;
#pragma unroll
                for (int bj = 0; bj < 2; ++bj) { const f32x4 v0 = acc[ai][bj][m][0] + bv[bj][0], v1 = acc[ai][bj][m][1] + bv[bj][1];
                    u32x4 w; w.x = cvt_pk_bf16(sigmoid_f(v0[0]), sigmoid_f(v0[1])); w.y = cvt_pk_bf16(sigmoid_f(v0[2]), sigmoid_f(v0[3]));
                    w.z = cvt_pk_bf16(sigmoid_f(v1[0]), sigmoid_f(v1[1])); w.w = cvt_pk_bf16(sigmoid_f(v1[2]), sigmoid_f(v1[3]));
                    *(u32x4*)(rowp + bj * HALF) = w; } }
    }
    __device__ __forceinline__ void mid(f32x4 (&)[2][2][4][2], const Unit&, int, int, int, int) const {}
};

struct EpiMerged {
    static constexpr bool PERM = true, AFTER_DRAIN = false;
    const bf16_t* gate; bf16_t* out;
    __device__ __forceinline__ void mid(f32x4 (&acc)[2][2][4][2], const Unit& u, int wr, int wc, int fr, int fq) const {
        const int row0 = u.pm * BM + wr * 64 + fr, col0 = u.pn * BM + wc * 32 + 8 * fq;
#pragma unroll
        for (int ai = 0; ai < 2; ++ai)
#pragma unroll
            for (int m = 0; m < 4; ++m) { const bf16_t* gp = gate + (size_t)(row0 + ai * HALF + m * 16) * 2048 + col0;
#pragma unroll
                for (int bj = 0; bj < 2; ++bj) { const u32x4 a = *(const u32x4*)(gp + bj * HALF), c = *(const u32x4*)(gp + 1024 + bj * HALF);
                    f32x4 r0, r1;
                    r0[0] = bf_lo(a.x) / bf_lo(c.x); r0[1] = bf_hi(a.x) / bf_hi(c.x); r0[2] = bf_lo(a.y) / bf_lo(c.y); r0[3] = bf_hi(a.y) / bf_hi(c.y);
                    r1[0] = bf_lo(a.z) / bf_lo(c.z); r1[1] = bf_hi(a.z) / bf_hi(c.z); r1[2] = bf_lo(a.w) / bf_lo(c.w); r1[3] = bf_hi(a.w) / bf_hi(c.w);
                    acc[ai][bj][m][0] *= r0; acc[ai][bj][m][1] *= r1; } }
    }
    __device__ __forceinline__ void operator()(const f32x4 (&acc)[2][2][4][2], const Unit& u, int wr, int wc, int fr, int fq) const {
        const int row0 = u.pm * BM + wr * 64 + fr, col0 = u.pn * BM + wc * 32 + 8 * fq;
#pragma unroll
        for (int ai = 0; ai < 2; ++ai)
#pragma unroll
            for (int m = 0; m < 4; ++m) { const size_t r = (size_t)(row0 + ai * HALF + m * 16); const bf16_t* gp = gate + r * 2048 + 1024 + col0; bf16_t* op = out + r * 1024 + col0;
#pragma unroll
                for (int bj = 0; bj < 2; ++bj) { const u32x4 c = *(const u32x4*)(gp + bj * HALF); const f32x4 v0 = acc[ai][bj][m][0], v1 = acc[ai][bj][m][1];
                    u32x4 w; w.x = cvt_pk_bf16(v0[0] * bf_lo(c.x), v0[1] * bf_hi(c.x)); w.y = cvt_pk_bf16(v0[2] * bf_lo(c.y), v0[3] * bf_hi(c.y));
                    w.z = cvt_pk_bf16(v1[0] * bf_lo(c.z), v1[1] * bf_hi(c.z)); w.w = cvt_pk_bf16(v1[2] * bf_lo(c.w), v1[3] * bf_hi(c.w));
                    *(u32x4*)(op + bj * HALF) = w; } }
    }
};

struct EpiOut {
    static constexpr bool PERM = false, AFTER_DRAIN = false;
    const float* x; float* out; const float* modr;
    __device__ __forceinline__ void operator()(const f32x4 (&acc)[2][2][4][2], const Unit& u, int wr, int wc, int fr, int fq) const {
        const int row0 = u.pm * BM + wr * 64 + fr, col0 = u.pn * BM + wc * 32 + 4 * fq; const int b = u.pm >> 5;
        f32x4 g1[2][2];
#pragma unroll
        for (int bj = 0; bj < 2; ++bj)
#pragma unroll
            for (int n = 0; n < 2; ++n) g1[bj][n] = *(const f32x4*)(modr + b * 3072 + 2048 + col0 + bj * HALF + n * 16) + 1.0f;
#pragma unroll
        for (int ai = 0; ai < 2; ++ai)
#pragma unroll
            for (int m = 0; m < 4; ++m) { const size_t off = (size_t)(row0 + ai * HALF + m * 16) * 1024 + col0;
#pragma unroll
                for (int bj = 0; bj < 2; ++bj)
#pragma unroll
                    for (int n = 0; n < 2; ++n) { const f32x4 xv = *(const f32x4*)(x + off + bj * HALF + n * 16);
                        *(f32x4*)(out + off + bj * HALF + n * 16) = xv * 1.189207115002721f + g1[bj][n] * acc[ai][bj][m][n]; }
                if (m & 1) asm volatile("" ::: "memory"); }
    }
    __device__ __forceinline__ void mid(f32x4 (&)[2][2][4][2], const Unit&, int, int, int, int) const {}
};

template <class Epi, class Sched, bool ALIGN_EPI = false, bool SP2 = false, bool DUAL = false>
__device__ __forceinline__ void gemm_phase(PG8_LAS unsigned char* lds, const Gemm g, const Sched& S, const Epi& E) {
    const int tid = threadIdx.x, wid = __builtin_amdgcn_readfirstlane(tid >> 6), lane = tid & 63, wr = wid >> 2, wc = wid & 3, fr = lane & 15, fq = lane >> 4;
    const int K = g.K, nt = K / BK;
    unsigned voffA[2], voffB[2];
#pragma unroll
    for (int i = 0; i < 2; ++i) { int R, C; stage_rc(tid * 16 + i * 8192, R, C); const int Rb = Epi::PERM ? ((R & ~31) + perm32(R & 31)) : R;
        voffA[i] = (unsigned)(R * K + C) * 2u; voffB[i] = (unsigned)(Rb * K + C) * 2u; }
    const size_t kstep = (size_t)(BK * 2);
    const size_t hstep = (size_t)HALF * K * 2;
    const size_t tstep = 2 * hstep;
    const unsigned ldsw = (unsigned)wid * 1024u;
    const int aoff = lds_byte(wr * 64 + fr, fq * 8), boff = lds_byte(wc * 32 + fr, fq * 8);
#define PG8_SA(b, h) (((b) * 2 + (h)) * HTB)
#define PG8_SB(b, h) ((4 + (b) * 2 + (h)) * HTB)
#define PG8_STAGE(bufoff, gbase, voff) do { _Pragma("unroll") for (int _i = 0; _i < 2; ++_i) \
        __builtin_amdgcn_global_load_lds((const unsigned*)((const char*)(gbase) + (voff)[_i]), (PG8_LAS unsigned*)(lds + (bufoff) + ldsw + _i * 8192), 16, 0, 0); } while (0)
#define PG8_LDA(dst, b, h) do { _Pragma("unroll") for (int m = 0; m < 4; ++m) _Pragma("unroll") for (int k = 0; k < 2; ++k) dst[m][k] = *(const PG8_LAS bf16x8*)(lds + PG8_SA(b, h) + aoff + m * 2048 + k * 1024); } while (0)
#define PG8_LDB(dst, b, h) do { _Pragma("unroll") for (int n = 0; n < 2; ++n) _Pragma("unroll") for (int k = 0; k < 2; ++k) dst[n][k] = *(const PG8_LAS bf16x8*)(lds + PG8_SB(b, h) + boff + n * 2048 + k * 1024); } while (0)
#define PG8_MMA(ai, bj, At, Bt) do { __builtin_amdgcn_s_setprio(1); _Pragma("unroll") for (int m = 0; m < 4; ++m) _Pragma("unroll") for (int n = 0; n < 2; ++n) _Pragma("unroll") for (int k = 0; k < 2; ++k) \
        acc[ai][bj][m][n] = __builtin_amdgcn_mfma_f32_16x16x32_bf16(Bt[n][k], At[m][k], acc[ai][bj][m][n], 0, 0, 0); __builtin_amdgcn_s_setprio(0); } while (0)
#define PG8_WAIT_V(n) asm volatile("s_waitcnt vmcnt(" #n ")" ::: "memory")
#define PG8_WAIT_L(n) asm volatile("s_waitcnt lgkmcnt(" #n ")" ::: "memory")
#define PG8_BAR __builtin_amdgcn_s_barrier()
#define PG8_SCHED __builtin_amdgcn_sched_barrier(0)
    Unit cur, nxt; int ui = 0;
    if (!S.next(0, cur)) return;
    f32x4 acc[2][2][4][2];
#pragma unroll
    for (int a = 0; a < 2; ++a)
#pragma unroll
        for (int b = 0; b < 2; ++b)
#pragma unroll
            for (int m = 0; m < 4; ++m)
#pragma unroll
                for (int n = 0; n < 2; ++n) acc[a][b][m][n] = (f32x4){0.f, 0.f, 0.f, 0.f};
    bf16x8 At[4][2], B0[2][2], B1[2][2];
#define PG8_BASEA(u_) ((const char*)((DUAL && (u_).half) ? g.A2 : g.A) + (size_t)(u_).pm * tstep)
#define PG8_BASEB(u_) ((const char*)((DUAL && (u_).half) ? g.Bt2 : g.Bt) + (size_t)(u_).pn * tstep)
    const char* cA = PG8_BASEA(cur); const char* cB = PG8_BASEB(cur);
    if constexpr (SP2) {
        PG8_STAGE(PG8_SB(0, 0), cB, voffB); PG8_STAGE(PG8_SB(0, 1), cB + hstep, voffB); PG8_STAGE(PG8_SA(0, 0), cA, voffA); PG8_STAGE(PG8_SA(0, 1), cA + hstep, voffA);
        if (wr == 1) PG8_BAR;
        PG8_WAIT_V(2); PG8_BAR;
        PG8_STAGE(PG8_SB(1, 0), cB + kstep, voffB); PG8_STAGE(PG8_SA(1, 0), cA + kstep, voffA); PG8_STAGE(PG8_SB(1, 1), cB + hstep + kstep, voffB);
        PG8_WAIT_V(6); PG8_BAR;
    } else {
        PG8_STAGE(PG8_SB(0, 0), cB, voffB); PG8_STAGE(PG8_SA(0, 0), cA, voffA); PG8_STAGE(PG8_SB(0, 1), cB + hstep, voffB); PG8_STAGE(PG8_SA(0, 1), cA + hstep, voffA);
        if (wr == 1) PG8_BAR;
        PG8_WAIT_V(4); PG8_BAR;
        PG8_STAGE(PG8_SB(1, 0), cB + kstep, voffB); PG8_STAGE(PG8_SA(1, 0), cA + kstep, voffA); PG8_STAGE(PG8_SB(1, 1), cB + hstep + kstep, voffB);
        PG8_WAIT_V(6); PG8_BAR;
    }
    for (;;) {
        const bool has_next = S.next(ui + 1, nxt);
        const char* nA = has_next ? PG8_BASEA(nxt) : cA; const char* nB = has_next ? PG8_BASEB(nxt) : cB;
        for (int t = 0; t < nt; t += 2) {
            const bool last = (t == nt - 2);
            const char* a1 = cA + (size_t)(t + 1) * kstep;
            const char* a2 = last ? nA : cA + (size_t)(t + 2) * kstep; const char* b2 = last ? nB : cB + (size_t)(t + 2) * kstep;
            const char* a3 = a2 + kstep; const char* b3 = b2 + kstep;
            if constexpr (SP2) {
            PG8_LDB(B0, 0, 0); PG8_LDB(B1, 0, 1); PG8_SCHED; PG8_LDA(At, 0, 0); PG8_STAGE(PG8_SA(1, 1), a1 + hstep, voffA);
            PG8_WAIT_V(8); PG8_WAIT_L(0); PG8_BAR; PG8_MMA(0, 0, At, B0); PG8_MMA(0, 1, At, B1); PG8_BAR; PG8_SCHED;
            PG8_LDA(At, 0, 1); PG8_STAGE(PG8_SB(0, 0), b2, voffB); PG8_STAGE(PG8_SB(0, 1), b2 + hstep, voffB); PG8_STAGE(PG8_SA(0, 0), a2, voffA);
            PG8_WAIT_V(8); PG8_WAIT_L(0); PG8_BAR; PG8_MMA(1, 0, At, B0); PG8_MMA(1, 1, At, B1); PG8_BAR; PG8_SCHED;
            PG8_LDB(B0, 1, 0); PG8_LDB(B1, 1, 1); PG8_SCHED; PG8_LDA(At, 1, 0); PG8_STAGE(PG8_SA(0, 1), a2 + hstep, voffA);
            PG8_WAIT_V(8); PG8_WAIT_L(0); PG8_BAR; PG8_MMA(0, 0, At, B0); PG8_MMA(0, 1, At, B1); PG8_BAR; PG8_SCHED;
            PG8_LDA(At, 1, 1); PG8_STAGE(PG8_SB(1, 0), b3, voffB); PG8_STAGE(PG8_SB(1, 1), b3 + hstep, voffB); PG8_STAGE(PG8_SA(1, 0), a3, voffA);
            PG8_WAIT_V(8); PG8_WAIT_L(0); PG8_BAR; PG8_MMA(1, 0, At, B0); PG8_MMA(1, 1, At, B1); PG8_BAR; PG8_SCHED;
            } else {
            PG8_LDB(B0, 0, 0); PG8_SCHED; PG8_LDA(At, 0, 0); PG8_STAGE(PG8_SA(1, 1), a1 + hstep, voffA);
            PG8_WAIT_L(8); PG8_BAR; PG8_WAIT_L(0); PG8_MMA(0, 0, At, B0); PG8_BAR; PG8_SCHED;
            PG8_LDB(B1, 0, 1); PG8_STAGE(PG8_SB(0, 0), b2, voffB);
            PG8_BAR; PG8_WAIT_L(0); PG8_MMA(0, 1, At, B1); PG8_BAR;
            PG8_LDA(At, 0, 1); PG8_STAGE(PG8_SA(0, 0), a2, voffA);
            PG8_BAR; PG8_WAIT_L(0); PG8_MMA(1, 0, At, B0); PG8_BAR; PG8_SCHED;
            PG8_STAGE(PG8_SB(0, 1), b2 + hstep, voffB);
            PG8_WAIT_V(6); PG8_BAR; PG8_MMA(1, 1, At, B1); PG8_BAR;
            PG8_LDB(B0, 1, 0); PG8_SCHED; PG8_LDA(At, 1, 0); PG8_STAGE(PG8_SA(0, 1), a2 + hstep, voffA);
            PG8_WAIT_L(8); PG8_BAR; PG8_WAIT_L(0); PG8_MMA(0, 0, At, B0); PG8_BAR; PG8_SCHED;
            PG8_LDB(B1, 1, 1); PG8_STAGE(PG8_SB(1, 0), b3, voffB);
            PG8_BAR; PG8_WAIT_L(0); PG8_MMA(0, 1, At, B1); PG8_BAR;
            PG8_LDA(At, 1, 1); PG8_STAGE(PG8_SA(1, 0), a3, voffA);
            PG8_BAR; PG8_WAIT_L(0); PG8_MMA(1, 0, At, B0); PG8_BAR; PG8_SCHED;
            PG8_STAGE(PG8_SB(1, 1), b3 + hstep, voffB);
            PG8_WAIT_V(6); PG8_BAR; PG8_MMA(1, 1, At, B1); PG8_BAR;
            }
        }
        if constexpr (ALIGN_EPI) { if (wr == 0) PG8_BAR; }
        if constexpr (DUAL) { if (cur.half == 0) E.mid(acc, cur, wr, wc, fr, fq); else E(acc, cur, wr, wc, fr, fq); }
        else if constexpr (!Epi::AFTER_DRAIN) { E(acc, cur, wr, wc, fr, fq); }
        if (!has_next) break;
        if (!DUAL || cur.half == 1) {
#pragma unroll
        for (int a = 0; a < 2; ++a)
#pragma unroll
            for (int b = 0; b < 2; ++b)
#pragma unroll
                for (int m = 0; m < 4; ++m)
#pragma unroll
                    for (int n = 0; n < 2; ++n) acc[a][b][m][n] = (f32x4){0.f, 0.f, 0.f, 0.f};
        }
        cur = nxt; cA = nA; cB = nB; ++ui;
        if constexpr (ALIGN_EPI) { if (wr == 1) PG8_BAR; }
    }
    PG8_WAIT_V(0);
    if constexpr (!ALIGN_EPI) { if (wr == 0) PG8_BAR; }
    PG8_BAR;
    if constexpr (Epi::AFTER_DRAIN) { E.fused(acc, cur, wr, wc, fr, fq, lds, wid, lane); }
#undef PG8_BASEA
#undef PG8_BASEB
#undef PG8_SA
#undef PG8_SB
#undef PG8_STAGE
#undef PG8_LDA
#undef PG8_LDB
#undef PG8_MMA
#undef PG8_WAIT_V
#undef PG8_WAIT_L
#undef PG8_BAR
#undef PG8_SCHED
}
}

namespace attn_body {
using bf16=__hip_bfloat16;
using bf16x8=__attribute__((ext_vector_type(8)))short;
using s16x4=__attribute__((ext_vector_type(4)))short;
using f32x16=__attribute__((ext_vector_type(16)))float;
using u32x4=__attribute__((ext_vector_type(4)))unsigned;
constexpr int SEQ=8192,DM=1024;
constexpr int NW=8,QBLK=32,QB=QBLK*NW,KVBLK=64,NQB=SEQ/QB;
__device__ __forceinline__ int crow(int r,int hi){return (r&3)+8*(r>>2)+4*hi;}
#define SBAR() __builtin_amdgcn_sched_barrier(0)
constexpr int NSLOT=3, KSLOT=8192, VSLOT=16384;
constexpr int LDS_K=0, LDS_V=NSLOT*KSLOT, LDS_WS=LDS_V+NSLOT*VSLOT, LDS_TBL=LDS_WS+NW*64*4, LDS_OST=LDS_TBL+3072, LDS_BYTES=LDS_OST+NW*8192;
constexpr int NBAND=6, TBL_N=640;
__device__ __forceinline__ void glds16(const void*gsrc,unsigned lds_dst){unsigned keep;
  asm volatile("s_mov_b32 %0, m0\n\ts_mov_b32 m0, %2\n\ts_nop 0\n\tglobal_load_lds_dwordx4 %1, off\n\ts_mov_b32 m0, %0":"=&s"(keep):"v"(gsrc),"s"(lds_dst):"memory");}
typedef float f32x2_t __attribute__((ext_vector_type(2))); typedef __bf16 bf16x2_t __attribute__((ext_vector_type(2)));
__device__ __forceinline__ unsigned cvtpk_s(float lo,float hi){f32x2_t v={lo,hi};bf16x2_t b=__builtin_convertvector(v,bf16x2_t);return __builtin_bit_cast(unsigned,b);}
#define WAIT_BAR(N) asm volatile("s_waitcnt vmcnt(" #N ") lgkmcnt(0)\n\ts_barrier":::"memory")
typedef __attribute__((address_space(3))) const char* lds_cptr;
typedef short v4i16_t __attribute__((ext_vector_type(4)));
__device__ __forceinline__ void kload2(bf16x8*kf,lds_cptr kp,int j){ kf[2*j]=*(const __attribute__((address_space(3))) bf16x8*)(kp+j*2048); kf[2*j+1]=*(const __attribute__((address_space(3))) bf16x8*)(kp+j*2048+512); }
__device__ __forceinline__ s16x4 vtr(lds_cptr p){ return __builtin_bit_cast(s16x4,__builtin_amdgcn_ds_read_tr16_b64_v4i16((__attribute__((address_space(3))) v4i16_t*)p)); }
#define MX3(a,b,c) __builtin_fmaxf(__builtin_fmaxf((a),(b)),(c))
__device__ __forceinline__ float rowmax(const f32x16&p0,const f32x16&p1){
  float a=MX3(p0[0],p0[1],p1[0]),b=MX3(p0[2],p0[3],p1[1]);a=MX3(a,p1[2],p1[3]);
  #pragma unroll
  for(int r=4;r<16;r+=4){a=MX3(a,p0[r],p0[r+1]);b=MX3(b,p0[r+2],p0[r+3]);a=MX3(a,p1[r],p1[r+1]);b=MX3(b,p1[r+2],p1[r+3]);}
  float m=__builtin_fmaxf(a,b);
  auto rr=__builtin_amdgcn_permlane32_swap(__float_as_uint(m),__float_as_uint(m),false,false);
  return __builtin_fmaxf(__uint_as_float(rr[0]),__uint_as_float(rr[1]));
}
__device__ __forceinline__ void tbladd(f32x16&p0,f32x16&p1,const __attribute__((address_space(3))) float*tbl,int kbrel,int qrel,int hi){
  unsigned ta=(unsigned)(uintptr_t)tbl+4u*(unsigned)(qrel+255-kbrel-4*hi-59); asm volatile("":"+v"(ta));
  const __attribute__((address_space(3))) float*tp=(const __attribute__((address_space(3))) float*)ta;
  #pragma unroll
  for(int r=0;r<16;++r){const int c=(r&3)+8*(r>>2); p0[r]+=tp[59-c]; p1[r]+=tp[27-c];}
}
__device__ __forceinline__ int t5_bucket(int n){ if(n<16)return n; const int lg=16+(int)(__logf((float)n*(1.0f/16.0f))*(16.0f/2.0794415416798357f)); return lg<31?lg:31; }

template<int THRL> __device__ __forceinline__ void attn_unit(int b,int h,int qb,const bf16*Q,const bf16*__restrict__ K,const bf16*__restrict__ V,const bf16*__restrict__ SZ,bf16*O,
                                                             const float*__restrict__ subln,const float*__restrict__ rel_bias,float lam,char*shm){
  int tid=threadIdx.x; asm volatile("":"+v"(tid));
  const int lane=tid&63,r32=lane&31,hi=lane>>5; const int wid=__builtin_amdgcn_readfirstlane(tid>>6);
  const long rowbase=(long)b*SEQ; const int q0=qb*QB;
  const unsigned lds0=(unsigned)(uintptr_t)shm;
  float*wsf=(float*)(shm+LDS_WS)+wid*64;
  const __attribute__((address_space(3))) float*tbl=(const __attribute__((address_space(3))) float*)((lds_cptr)shm+LDS_TBL);
  bf16*stg=(bf16*)(shm+LDS_OST)+wid*4096;
  { const float b31=rel_bias[31*8+h];
    for(int i=tid;i<TBL_N;i+=NW*64){ const int dist=i-255; float v=-INFINITY; if(dist>=0) v=(dist>=113)?0.f:(rel_bias[t5_bucket(dist)*8+h]-b31)*1.4426950408889634f; ((float*)(shm+LDS_TBL))[i]=v; } }
  const lds_cptr shm3=(lds_cptr)shm; const lds_cptr kp0=shm3+LDS_K+hi*1024+r32*16; const lds_cptr vp0=shm3+LDS_V+((lane>>4)&1)*32+(lane&3)*8+(4*hi+((lane&15)>>2))*64;
  const int NT=(q0+QB)/KVBLK;
  const int qrel=wid*QBLK+r32;
  f32x16 o[4];
  #pragma unroll 1
  for(int map=0;map<2;++map){
  const bf16*Qw=Q+(rowbase+q0+wid*QBLK)*DM+h*128+map*64;
  const bf16*Kh=K+rowbase*DM+h*128+map*64,*Vh=V+rowbase*DM+h*128;
  const bf16*ksrc=Kh+(long)lane*DM+wid*8;
  const bf16*vsrc=Vh+(long)(16*(wid&3)+(lane>>2))*DM+(wid>>2)*32+(lane&3)*8;
  const unsigned kdst=lds0+LDS_K+wid*1024, vdst=lds0+LDS_V+wid*1024;
  #define DMA_K(t,slot) glds16(ksrc+(long)(t)*KVBLK*DM,(unsigned)__builtin_amdgcn_readfirstlane(kdst+(slot)))
  #define DMA_V(t,slot) do{ glds16(vsrc+(long)(t)*KVBLK*DM,(unsigned)__builtin_amdgcn_readfirstlane(vdst+2*(slot))); glds16(vsrc+(long)(t)*KVBLK*DM+64,(unsigned)__builtin_amdgcn_readfirstlane(vdst+2*(slot)+8192)); }while(0)
  bf16x8 kf[8];
  DMA_K(0,0);DMA_V(0,0);DMA_K(1,KSLOT);
  bf16x8 qr[4];
  #pragma unroll
  for(int d0=0;d0<4;++d0)qr[d0]=*reinterpret_cast<const bf16x8*>(&Qw[(long)r32*DM+d0*16+hi*8]);
  float mhat=0.f,l_reg=0.f;
  #pragma unroll
  for(int d_=0;d_<4;++d_)o[d_]=f32x16{};
  #define TBLADD(P0,P1,t) do{ if((t)>=NT-NBAND) tbladd(P0,P1,tbl,64*(t)-q0,qrel,hi); }while(0)
  bool resc=false;
  #define RESC() do{ if(resc){ asm volatile("s_waitcnt lgkmcnt(0)":::"memory"); \
      _Pragma("unroll") for(int d_=0;d_<4;++d_) _Pragma("unroll") for(int r=0;r<16;++r)o[d_][r]*=wsf[crow(r,hi)]; } }while(0)
  f32x16 pA0,pA1,pB0,pB1;
  int sl_prev=0,sl_cur=0,sl_next=KSLOT;
  #define ROT() do{sl_prev=sl_cur;sl_cur=sl_next;sl_next=(sl_next==(NSLOT-1)*KSLOT)?0:sl_next+KSLOT;}while(0)
  DMA_K(2,2*KSLOT);
  WAIT_BAR(4);
  { const lds_cptr kb=kp0;
    #pragma unroll
    for(int d0=0;d0<4;++d0){
      const bf16x8 b0=*(const __attribute__((address_space(3))) bf16x8*)(kb+d0*2048);
      const bf16x8 b1=*(const __attribute__((address_space(3))) bf16x8*)(kb+d0*2048+512);
      if(d0==0){pA0=__builtin_amdgcn_mfma_f32_32x32x16_bf16(b0,qr[0],(f32x16{}),0,0,0);pA1=__builtin_amdgcn_mfma_f32_32x32x16_bf16(b1,qr[0],(f32x16{}),0,0,0);}
      else{pA0=__builtin_amdgcn_mfma_f32_32x32x16_bf16(b0,qr[d0],pA0,0,0,0);pA1=__builtin_amdgcn_mfma_f32_32x32x16_bf16(b1,qr[d0],pA1,0,0,0);}} }
  TBLADD(pA0,pA1,0);
  { const float rm=rowmax(pA0,pA1); mhat+=rm;
    #pragma unroll
    for(int r=0;r<16;++r){pA0[r]-=rm;pA1[r]-=rm;}
    #pragma unroll
    for(int r=0;r<16;++r){pA0[r]=__builtin_amdgcn_exp2f(pA0[r]);pA1[r]=__builtin_amdgcn_exp2f(pA1[r]);} }
  WAIT_BAR(0);
  DMA_K(3,0);DMA_V(1,KSLOT);
  ROT();
  #pragma unroll
  for(int j=0;j<4;++j)kload2(kf,kp0+sl_cur,j);
  WAIT_BAR(3);
  s16x4 vlo[8],vhi[8]; u32x4 pw0,pw1,pw2,pw3;
  #define PKW(P,B) cvtpk_s(P[B],P[B+1])
  #define PAF(k) __builtin_bit_cast(bf16x8,pw##k)
  #define VFR(i) (bf16x8){vlo[i][0],vlo[i][1],vlo[i][2],vlo[i][3],vhi[i][0],vhi[i][1],vhi[i][2],vhi[i][3]}
  #define PIN(x) asm volatile("":"+v"(x))
  #define GAPA(MF,A0,A1,A2,A3,W0,W1,PW) do{ MF; sacc+=A0; sacc+=A1; sacc+=A2; sacc+=A3; PIN(sacc); W0; W1; PIN(PW); SBAR(); }while(0)
  #define EX(v) __builtin_amdgcn_exp2f((v)+nmh)
  #define GAPB(MF,X,B) do{ MF; X[B]=EX(X[B]); X[B+1]=EX(X[B+1]); PIN(X); SBAR(); }while(0)
  #define VRD(s,f) do{ vlo[s]=vtr(vp_+(((f)>>2)*4096+((f)&3)*1024)); vhi[s]=vtr(vp_+(((f)>>2)*4096+((f)&3)*1024+512)); }while(0)
  #define KRD(G,j) do{ if(G){ kload2(kf,kp0+sl_next,j); SBAR(); } }while(0)
  #define PVM(ks,d0,s) o[d0]=__builtin_amdgcn_mfma_f32_32x32x16_bf16(PAF(ks),VFR(s),o[d0],0,0,0)
  #define STEP(C0,C1,P0,P1,t,GK,GV,GL) do{ SBAR(); \
    const lds_cptr vp_=vp0+2*sl_prev; \
    VRD(0,0); SBAR(); float sacc=(P0[0]+P0[1]); \
    GAPA(C0=__builtin_amdgcn_mfma_f32_32x32x16_bf16(kf[0],qr[0],(f32x16{}),0,0,0), P0[2],P0[3],P0[4],P0[5],     pw0[0]=PKW(P0,0), pw0[1]=PKW(P0,2), pw0); \
    VRD(1,4); SBAR(); GAPA(C1=__builtin_amdgcn_mfma_f32_32x32x16_bf16(kf[1],qr[0],(f32x16{}),0,0,0), P0[6],P0[7],P0[8],P0[9],     pw0[2]=PKW(P0,4), pw0[3]=PKW(P0,6), pw0); \
    VRD(2,8); SBAR(); GAPA(C0=__builtin_amdgcn_mfma_f32_32x32x16_bf16(kf[2],qr[1],C0,0,0,0),   P0[10],P0[11],P0[12],P0[13], pw1[0]=PKW(P0,8), pw1[1]=PKW(P0,10), pw1); \
    VRD(3,12); SBAR(); GAPA(C1=__builtin_amdgcn_mfma_f32_32x32x16_bf16(kf[3],qr[1],C1,0,0,0),   P0[14],P0[15],P1[0],P1[1],   pw1[2]=PKW(P0,12),pw1[3]=PKW(P0,14), pw1); \
    VRD(4,1); SBAR(); GAPA(C0=__builtin_amdgcn_mfma_f32_32x32x16_bf16(kf[4],qr[2],C0,0,0,0),   P1[2],P1[3],P1[4],P1[5],     pw2[0]=PKW(P1,0), pw2[1]=PKW(P1,2), pw2); \
    VRD(5,5); SBAR(); GAPA(C1=__builtin_amdgcn_mfma_f32_32x32x16_bf16(kf[5],qr[2],C1,0,0,0),   P1[6],P1[7],P1[8],P1[9],     pw2[2]=PKW(P1,4), pw2[3]=PKW(P1,6), pw2); \
    VRD(6,9); SBAR(); GAPA(C0=__builtin_amdgcn_mfma_f32_32x32x16_bf16(kf[6],qr[3],C0,0,0,0),   P1[10],P1[11],P1[12],P1[13], pw3[0]=PKW(P1,8), pw3[1]=PKW(P1,10), pw3); \
    VRD(7,13); SBAR(); GAPA(C1=__builtin_amdgcn_mfma_f32_32x32x16_bf16(kf[7],qr[3],C1,0,0,0),   P1[14],P1[15],0.f,0.f,       pw3[2]=PKW(P1,12),pw3[3]=PKW(P1,14), pw3); \
    l_reg+=sacc; \
    if(GK){DMA_K((t)+3,sl_cur);} if(GV){DMA_V((t)+1,sl_next);} \
    TBLADD(C0,C1,t); \
    { const float rm=rowmax(C0,C1)-mhat; \
      resc=false; \
      if(__builtin_expect(__any(rm>(float)THRL),0)){ const float dl=__builtin_fmaxf(rm,0.f); mhat+=dl; \
        const float f=__builtin_amdgcn_exp2f(-dl); l_reg*=f; if(hi==0)wsf[r32]=f; resc=true; } } \
    const float nmh=-mhat; SBAR(); \
    GAPB(PVM(0,0,0), C0,0);  VRD(0,2);  SBAR(); \
    GAPB(PVM(0,1,1), C0,2);  VRD(1,6);  SBAR(); \
    GAPB(PVM(0,2,2), C0,4);  VRD(2,10); SBAR(); \
    GAPB(PVM(0,3,3), C0,6);  VRD(3,14); SBAR(); \
    GAPB(PVM(1,0,4), C0,8);  VRD(4,3);  SBAR(); \
    GAPB(PVM(1,1,5), C0,10); VRD(5,7);  SBAR(); \
    GAPB(PVM(1,2,6), C0,12); VRD(6,11); SBAR(); \
    GAPB(PVM(1,3,7), C0,14); VRD(7,15); SBAR(); \
    GAPB(PVM(2,0,0), C1,0); \
    KRD(GL,0); GAPB(PVM(2,1,1), C1,2); \
    KRD(GL,1); GAPB(PVM(2,2,2), C1,4); \
    KRD(GL,2); GAPB(PVM(2,3,3), C1,6); \
    KRD(GL,3); GAPB(PVM(3,0,4), C1,8); \
    GAPB(PVM(3,1,5), C1,10); \
    GAPB(PVM(3,2,6), C1,12); \
    GAPB(PVM(3,3,7), C1,14); \
    }while(0)
  int t=1;
  for(;t+NBAND+1<NT;t+=2){
    #undef TBLADD
    #define TBLADD(P0,P1,t) do{}while(0)
    STEP(pB0,pB1,pA0,pA1,t,true,true,true);     WAIT_BAR(3); RESC(); ROT();
    STEP(pA0,pA1,pB0,pB1,t+1,true,true,true);   WAIT_BAR(3); RESC(); ROT();
  }
  #undef TBLADD
  #define TBLADD(P0,P1,t) do{ if((t)>=NT-NBAND) tbladd(P0,P1,tbl,64*(t)-q0,qrel,hi); }while(0)
  #define ENDW(tt) do{ if((tt)+3<NT){WAIT_BAR(3);} else if((tt)+2<NT){WAIT_BAR(2);} else {WAIT_BAR(0);} }while(0)
  for(;t+1<NT;t+=2){
    STEP(pB0,pB1,pA0,pA1,t,(t+3<NT),(t+1<NT),(t+1<NT));       ENDW(t);   RESC(); ROT();
    STEP(pA0,pA1,pB0,pB1,t+1,(t+4<NT),(t+2<NT),(t+2<NT));     ENDW(t+1); RESC(); ROT();
  }
  STEP(pB0,pB1,pA0,pA1,NT-1,false,false,false); RESC();
  { float sacc=pB0[0]+pB0[1]; _Pragma("unroll") for(int r=2;r<16;++r)sacc+=pB0[r]; _Pragma("unroll") for(int r=0;r<16;++r)sacc+=pB1[r]; l_reg+=sacc;
    pw0=(u32x4){PKW(pB0,0),PKW(pB0,2),PKW(pB0,4),PKW(pB0,6)};pw1=(u32x4){PKW(pB0,8),PKW(pB0,10),PKW(pB0,12),PKW(pB0,14)};pw2=(u32x4){PKW(pB1,0),PKW(pB1,2),PKW(pB1,4),PKW(pB1,6)};pw3=(u32x4){PKW(pB1,8),PKW(pB1,10),PKW(pB1,12),PKW(pB1,14)};
    SBAR(); const lds_cptr vp_=vp0+2*sl_cur;
    _Pragma("unroll") for(int i=0;i<8;++i){ VRD(i,(i&3)*4+(i>>2)); }
    PVM(0,0,0);PVM(0,1,1);PVM(0,2,2);PVM(0,3,3);PVM(1,0,4);PVM(1,1,5);PVM(1,2,6);PVM(1,3,7); SBAR();
    _Pragma("unroll") for(int i=0;i<8;++i){ VRD(i,(i&3)*4+(i>>2)+2); }
    PVM(2,0,0);PVM(2,1,1);PVM(2,2,2);PVM(2,3,3);PVM(3,0,4);PVM(3,1,5);PVM(3,2,6);PVM(3,3,7); }
  #undef PKW
  #undef PAF
  #undef VFR
  #undef PIN
  #undef GAPA
  #undef GAPB
  #undef EX
  #undef VRD
  #undef KRD
  #undef PVM
  #undef STEP
  #undef ENDW
  #undef TBLADD
  #undef RESC
  #undef ROT
  #undef DMA_K
  #undef DMA_V
  int lane_e=lane; asm volatile("":"+v"(lane_e)); const int r32e=lane_e&31, hie=lane_e>>5;
  {auto rr=__builtin_amdgcn_permlane32_swap(__float_as_uint(l_reg),__float_as_uint(l_reg),false,false);l_reg=__uint_as_float(rr[0])+__uint_as_float(rr[1]);}
  if(hie==0)wsf[32+r32e]=l_reg;asm volatile("s_waitcnt lgkmcnt(0)":::"memory");
  float rli[16];
  #pragma unroll
  for(int r=0;r<16;++r)rli[r]=__builtin_amdgcn_rcpf(wsf[32+crow(r,hie)]);
  if(map==0){
    #pragma unroll
    for(int r=0;r<16;++r){const int orow=crow(r,hie);
      #pragma unroll
      for(int d0=0;d0<4;++d0)stg[orow*128+d0*32+r32e]=__float2bfloat16(o[d0][r]*rli[r]);}
    asm volatile("s_waitcnt lgkmcnt(0)\n\ts_barrier":::"memory");
  } else {
    float ss[16];
    #pragma unroll
    for(int r=0;r<16;++r){const int orow=crow(r,hie); float s=0.f;
      #pragma unroll
      for(int d0=0;d0<4;++d0){ const float v=__bfloat162float(stg[orow*128+d0*32+r32e])-lam*(o[d0][r]*rli[r]); o[d0][r]=v; s+=v*v; }
      ss[r]=s; }
    #pragma unroll
    for(int r=0;r<16;++r){ float s=ss[r];
      #pragma unroll
      for(int of=1;of<32;of<<=1)s+=__shfl_xor(s,of);
      ss[r]=0.8f/sqrtf(s*(1.0f/128.0f)+1e-5f); }
    float gn[4];
    #pragma unroll
    for(int d0=0;d0<4;++d0)gn[d0]=subln[d0*32+r32e];
    #pragma unroll
    for(int r=0;r<16;++r){const int orow=crow(r,hie);
      #pragma unroll
      for(int d0=0;d0<4;++d0)stg[orow*128+d0*32+r32e]=__float2bfloat16(o[d0][r]*ss[r]*gn[d0]);}
    asm volatile("s_waitcnt lgkmcnt(0)":::"memory");
    const long orow0=rowbase+q0+wid*QBLK;
    #pragma unroll
    for(int i=0;i<8;++i){const int row=i*4+(lane_e>>4),ch=lane_e&15; const u32x4 v=*(const u32x4*)(stg+row*128+ch*8); const long g=(orow0+row)*DM+h*128+ch*8; const u32x4 z=*(const u32x4*)(SZ+g);
      u32x4 w;
      w.x=cvtpk_s(__uint_as_float(v.x<<16)*__uint_as_float(z.x<<16),__uint_as_float(v.x&0xffff0000u)*__uint_as_float(z.x&0xffff0000u));
      w.y=cvtpk_s(__uint_as_float(v.y<<16)*__uint_as_float(z.y<<16),__uint_as_float(v.y&0xffff0000u)*__uint_as_float(z.y&0xffff0000u));
      w.z=cvtpk_s(__uint_as_float(v.z<<16)*__uint_as_float(z.z<<16),__uint_as_float(v.z&0xffff0000u)*__uint_as_float(z.z&0xffff0000u));
      w.w=cvtpk_s(__uint_as_float(v.w<<16)*__uint_as_float(z.w<<16),__uint_as_float(v.w&0xffff0000u)*__uint_as_float(z.w&0xffff0000u));
      *(u32x4*)(O+g)=w; }
    asm volatile("s_waitcnt lgkmcnt(0)\n\ts_barrier":::"memory");
  }
  }
}
constexpr int ATTN_LDS_BYTES=LDS_BYTES;
#undef SBAR
#undef WAIT_BAR
#undef MX3
}

constexpr int NWAVES = 8;
#ifndef MK_N_LAUNCHES
#define MK_N_LAUNCHES 1
#endif
constexpr int N_LAUNCHES = MK_N_LAUNCHES;
#if MK_N_LAUNCHES == 1
#define LAUNCH_CUTS {0, 8}
#elif MK_N_LAUNCHES == 8
#define LAUNCH_CUTS {0, 1, 2, 3, 4, 5, 6, 7, 8}
#endif

constexpr int BATCH = 4, T = 8192, D = 1024;
constexpr int M = BATCH * T;
constexpr int NPROJ = 8192, NGATE = 2048;
constexpr float LN_EPS = 1e-5f, RMS_EPS = 1e-5f;

constexpr size_t MiB = 1u << 20;
constexpr size_t WS_CTL = 0, CTL_ZERO_BYTES = 128 * 1024;
constexpr size_t WS_MODP = 1 * MiB, WS_MODR = WS_MODP + 512 * 1024;
constexpr size_t WS_BT1 = 2 * MiB, WS_WB0 = 22 * MiB, WS_WB1 = 24 * MiB, WS_WO = 26 * MiB;
constexpr size_t WS_Q = 32 * MiB, WS_K = 96 * MiB, WS_V = 160 * MiB, WS_SZ = 224 * MiB;
constexpr size_t WS_WC = 288 * MiB, WS_GC = 352 * MiB, WS_U = 416 * MiB, WS_END = 480 * MiB;
static_assert(WS_K - WS_Q == WS_V - WS_K && WS_V - WS_K == WS_SZ - WS_V && (size_t)M * D * 2 == 64 * MiB, "d_ws map");
constexpr int CW_BAR = 1024;

constexpr int RING_OFF = 0, RING_BYTES = 147456;
constexpr int LDSCTL_OFF = RING_BYTES, MISC_OFF = LDSCTL_OFF + 320;
constexpr int LDS_BYTES = 148480;
static_assert(MISC_OFF + 128 <= LDS_BYTES && attn_body::ATTN_LDS_BYTES <= RING_BYTES && pg8::STAGE_BYTES <= RING_BYTES, "LDS map");

#define GAS __attribute__((address_space(1)))
#define LAS __attribute__((address_space(3)))
typedef unsigned short bf16;
typedef unsigned v4u __attribute__((ext_vector_type(4)));
typedef float f32x4 __attribute__((ext_vector_type(4)));
typedef short bf16x8 __attribute__((ext_vector_type(8)));
typedef GAS unsigned gu32;
typedef GAS unsigned long long gu64;
#define RLX_AGENT __ATOMIC_RELAXED, __HIP_MEMORY_SCOPE_AGENT
#define LDS_WAIT() asm volatile("s_waitcnt lgkmcnt(0)" ::: "memory")
#define VM_WAIT() asm volatile("s_waitcnt vmcnt(0)" ::: "memory")
__device__ __forceinline__ unsigned long long rt() { return __builtin_amdgcn_s_memrealtime(); }
__device__ __forceinline__ unsigned f2bf(float f) { unsigned u = __builtin_bit_cast(unsigned, f); return (u + 0x7fffu + ((u >> 16) & 1u)) >> 16; }
__device__ __forceinline__ unsigned pk2(float lo, float hi) { return f2bf(lo) | (f2bf(hi) << 16); }

#define XB_TMO      128
#define XB_XCNT(j)  (256  + 64 * (j))
#define XB_XSUB(j)  (1280 + 64 * (j))
#define XB_XGEN(j)  (2304 + 64 * (j))
#define XB_TOP      3328
#define XB_TOPGEN   3392
#define XCD_BAR_WORDS 3456
#define XB_SPIN_CAP (1u << 18)

__device__ __forceinline__ unsigned xb_ld(unsigned* p)              { return __hip_atomic_load(p, __ATOMIC_RELAXED, __HIP_MEMORY_SCOPE_AGENT); }
__device__ __forceinline__ unsigned xb_add(unsigned* p, unsigned v) { return __hip_atomic_fetch_add(p, v, __ATOMIC_RELAXED, __HIP_MEMORY_SCOPE_AGENT); }
__device__ __forceinline__ unsigned xb_xcc_id() { return (unsigned)__builtin_amdgcn_s_getreg((3 << 11) | 20) & 0xFu; }
#define XB_SPIN(cond, bar) do { unsigned _sp = 0; while (cond) { __builtin_amdgcn_s_sleep(1); \
    if ((++_sp & 255u) == 0u) { if (xb_ld(&(bar)[XB_TMO])) break; if (_sp > XB_SPIN_CAP) { atomicAdd(&(bar)[XB_TMO], 1u); break; } } } } while (0)

struct XcdBarrier {
    unsigned* bar; unsigned x;
    volatile LAS unsigned* st;
};

__device__ __forceinline__ XcdBarrier xcd_barrier_post(unsigned* bar, volatile LAS unsigned* st) {
    XcdBarrier b; b.bar = bar; b.x = xb_xcc_id(); b.st = st;
    if (threadIdx.x == 0) (void)xb_add(&bar[XB_XCNT(b.x)], 1u);
    return b;
}
__device__ __forceinline__ void xcd_barrier_complete(unsigned* bar, unsigned x, unsigned& nloc, unsigned& nx) {
    const unsigned G = gridDim.x * gridDim.y * gridDim.z;
    unsigned sum, cnt, mine, sp = 0u;
    for (;;) {
        sum = 0u; cnt = 0u; mine = 0u;
#pragma unroll
        for (unsigned j = 0; j < 16; ++j) { const unsigned c = xb_ld(&bar[XB_XCNT(j)]); sum += c; cnt += (c > 0u) ? 1u : 0u; mine = (j == x) ? c : mine; }
        if (sum == G) break;
        __builtin_amdgcn_s_sleep(1);
        if ((++sp & 255u) == 0u) { if (xb_ld(&bar[XB_TMO])) break; if (sp > XB_SPIN_CAP) { atomicAdd(&bar[XB_TMO], 1u); break; } }
    }
    nloc = mine > 0u ? mine : 1u; nx = cnt > 0u ? cnt : 1u;
}

__device__ __forceinline__ void xcd_barrier(const XcdBarrier& b) {
    asm volatile("s_waitcnt vmcnt(0)" ::: "memory");
    __syncthreads();
    if (threadIdx.x == 0) {
        unsigned* bar = b.bar;
        __builtin_amdgcn_s_waitcnt(0);
        unsigned nloc = b.st[0], nx = b.st[1];
        if (nloc == 0u) { xcd_barrier_complete(bar, b.x, nloc, nx); b.st[0] = nloc; b.st[1] = nx; }
        const unsigned old = xb_add(&bar[XB_XSUB(b.x)], 1u);
        const unsigned gen = old / nloc;
        if (old + 1u == (gen + 1u) * nloc) {
            __builtin_amdgcn_fence(__ATOMIC_RELEASE, "agent");
            asm volatile("s_waitcnt vmcnt(0)" ::: "memory");
            const unsigned og = xb_add(&bar[XB_TOP], 1u);
            const unsigned tg = og / nx;
            if (og + 1u == (tg + 1u) * nx) xb_add(&bar[XB_TOPGEN], 1u);
            else XB_SPIN(xb_ld(&bar[XB_TOPGEN]) == tg, bar);
            __builtin_amdgcn_fence(__ATOMIC_ACQUIRE, "agent");
            xb_add(&bar[XB_XGEN(b.x)], 1u);
            asm volatile("s_waitcnt vmcnt(0)" ::: "memory");
        } else {
            XB_SPIN(xb_ld(&bar[XB_XGEN(b.x)]) == gen, bar);
            __builtin_amdgcn_fence(__ATOMIC_ACQUIRE, "agent");
            asm volatile("s_waitcnt vmcnt(0)" ::: "memory");
        }
    }
    __syncthreads();
}

struct Frame {
    LAS unsigned char* lds;
    volatile LAS unsigned* MISC;
    gu32* ctl;
    int tid, lane, wave;
    int vcu, G;
    const float *x, *c, *w_ada, *b_ada, *w_in, *lq1, *lk1, *lq2, *lk2, *subln, *rel_bias, *conv_w, *w_branch, *w_gate, *b_gate, *w_out, *ln_gain, *ln_bias;
    float* out;
    bf16 *Bt1, *WB0t, *WB1t, *WOt;
    bf16 *Qb, *Kb, *Vb, *SZ, *Wc, *Gc, *U, *YA, *GATE, *MRG;
    float *PRE;
    float *modp, *modr;
};

__device__ __forceinline__ float wave_sum(float v) {
#pragma unroll
    for (int o = 1; o < 64; o <<= 1) v += __shfl_xor(v, o);
    return v;
}
__device__ __forceinline__ int bt1_row(int s) {
    if (s < 4096) return s;
    const int kind = (s - 4096) >> 10, ch = s & 1023, ct = ch >> 6, cl = ch & 63;
    return 4096 + 256 * ct + 128 * (kind >> 1) + 8 * (cl >> 2) + 4 * (kind & 1) + (cl & 3);
}
template <bool PERMW>
__device__ __forceinline__ void p0_transpose_item(const float* W, int K, int N, bf16* WT, int row_off, LAS float* scr, int item, int lane) {
    const int nblk = N / 32, kb = item / nblk, nb = item % nblk, k0 = 64 * kb, n0 = 32 * nb;
#pragma unroll 8
    for (int i = 0; i < 32; ++i) { const int kk = 2 * i + (lane >> 5); scr[kk * 33 + (lane & 31)] = W[(size_t)(k0 + kk) * N + n0 + (lane & 31)]; }
    LDS_WAIT(); asm volatile("" ::: "memory");
    const int c = lane & 7;
#pragma unroll
    for (int j = 0; j < 4; ++j) { const int n = (lane >> 3) + 8 * j; const LAS float* s = scr + (8 * c) * 33 + n;
        v4u o; o.x = pk2(s[0 * 33], s[1 * 33]); o.y = pk2(s[2 * 33], s[3 * 33]); o.z = pk2(s[4 * 33], s[5 * 33]); o.w = pk2(s[6 * 33], s[7 * 33]);
        const int drow = PERMW ? bt1_row(n0 + n) : (row_off + n0 + n);
        *(GAS v4u*)(WT + (size_t)drow * K + k0 + 8 * c) = o; }
    LDS_WAIT(); asm volatile("" ::: "memory");
}
__device__ __forceinline__ void p0_mod_item(Frame& F, LAS float* scr, int item) {
    const int cg = item % 48, kc = item / 48, col = cg * 64 + F.lane, k0 = kc * 128;
#pragma unroll
    for (int i = 0; i < 8; ++i) { const int e = i * 64 + F.lane; scr[e] = F.c[(e >> 7) * D + k0 + (e & 127)]; }
    LDS_WAIT(); asm volatile("" ::: "memory");
    float a0 = 0.f, a1 = 0.f, a2 = 0.f, a3 = 0.f;
    const float* wp = F.w_ada + (size_t)k0 * 3072 + col;
#pragma unroll 8
    for (int k = 0; k < 128; ++k) { const float w = wp[(size_t)k * 3072]; a0 += scr[k] * w; a1 += scr[128 + k] * w; a2 += scr[256 + k] * w; a3 += scr[384 + k] * w; }
    float* mp = F.modp + (size_t)kc * 4 * 3072 + col;
    mp[0] = a0; mp[3072] = a1; mp[2 * 3072] = a2; mp[3 * 3072] = a3;
    LDS_WAIT(); asm volatile("" ::: "memory");
}
__device__ __forceinline__ void p0_prologue(Frame& F) {
    LAS float* scr = (LAS float*)(F.lds + RING_OFF + F.wave * 16384);
    const int gw = F.vcu * NWAVES + F.wave, NGW = F.G * NWAVES;
    constexpr int I_MOD = 48 * 8, I_IN = (D / 64) * (8192 / 32), I_G = (D / 64) * (2048 / 32), I_B = (D / 64) * (D / 32);
    constexpr int NITEMS = I_MOD + I_IN + I_G + 3 * I_B;
    for (int it = gw; it < NITEMS; it += NGW) {
        int r = it;
        if (r < I_MOD) { p0_mod_item(F, scr, r); continue; } r -= I_MOD;
        if (r < I_IN) { p0_transpose_item<true>(F.w_in, D, 8192, F.Bt1, 0, scr, r, F.lane); continue; } r -= I_IN;
        if (r < I_G) { p0_transpose_item<false>(F.w_gate, D, 2048, F.Bt1, 8192, scr, r, F.lane); continue; } r -= I_G;
        if (r < I_B) { p0_transpose_item<false>(F.w_branch, D, D, F.WB0t, 0, scr, r, F.lane); continue; } r -= I_B;
        if (r < I_B) { p0_transpose_item<false>(F.w_branch + (size_t)D * D, D, D, F.WB1t, 0, scr, r, F.lane); continue; } r -= I_B;
        p0_transpose_item<false>(F.w_out, D, D, F.WOt, 0, scr, r, F.lane);
    }
}
__device__ __forceinline__ void p0b_adaln(Frame& F) {
    LAS float* ms = (LAS float*)(F.lds + RING_OFF);
    const int j = F.vcu, b = j >> 6;
    for (int e = F.tid; e < 3072; e += NWAVES * 64) { float s = F.b_ada[e];
#pragma unroll
        for (int kc = 0; kc < 8; ++kc) s += F.modp[(size_t)(kc * 4 + b) * 3072 + e];
        ms[e] = s; if ((j & 63) == 0) F.modr[b * 3072 + e] = s; }
    __syncthreads();
    for (int rr = F.wave; rr < 128; rr += NWAVES) {
        const size_t m = (size_t)j * 128 + rr;
        const GAS f32x4* xr = (const GAS f32x4*)(F.x + m * D) + F.lane;
        f32x4 v[4]; float s = 0.f;
#pragma unroll
        for (int q = 0; q < 4; ++q) { v[q] = xr[64 * q]; s += (v[q].x + v[q].y) + (v[q].z + v[q].w); }
        const float mean = wave_sum(s) * (1.f / D); float s2 = 0.f;
#pragma unroll
        for (int q = 0; q < 4; ++q) { v[q] = v[q] - mean; s2 += (v[q].x * v[q].x + v[q].y * v[q].y) + (v[q].z * v[q].z + v[q].w * v[q].w); }
        const float rstd = 1.f / sqrtf(wave_sum(s2) * (1.f / D) + LN_EPS);
        GAS unsigned long long* o8 = (GAS unsigned long long*)(F.U + m * D) + F.lane;
#pragma unroll
        for (int q = 0; q < 4; ++q) { const int col = 256 * q + 4 * F.lane; const f32x4 sh = *(const LAS f32x4*)(ms + col), sc = *(const LAS f32x4*)(ms + 1024 + col);
            const f32x4 y = v[q] * rstd * (sc + 1.0f) + sh;
            o8[64 * q] = (unsigned long long)pk2(y.x, y.y) | ((unsigned long long)pk2(y.z, y.w) << 32); }
    }
}
__device__ __forceinline__ void p5_final_ln(Frame& F) {
    const int gw = F.vcu * NWAVES + F.wave, NGW = F.G * NWAVES;
    f32x4 gn[4], bs[4];
#pragma unroll
    for (int q = 0; q < 4; ++q) { gn[q] = *((const GAS f32x4*)F.ln_gain + F.lane + 64 * q); bs[q] = *((const GAS f32x4*)F.ln_bias + F.lane + 64 * q); }
    for (int m = gw; m < M; m += NGW) {
        const GAS f32x4* xr = (const GAS f32x4*)(F.PRE + (size_t)m * D) + F.lane; GAS f32x4* orow = (GAS f32x4*)(F.out + (size_t)m * D) + F.lane;
        f32x4 v[4]; float s = 0.f;
#pragma unroll
        for (int q = 0; q < 4; ++q) { v[q] = xr[64 * q]; s += (v[q].x + v[q].y) + (v[q].z + v[q].w); }
        const float mean = wave_sum(s) * (1.f / D); float s2 = 0.f;
#pragma unroll
        for (int q = 0; q < 4; ++q) { v[q] = v[q] - mean; s2 += (v[q].x * v[q].x + v[q].y * v[q].y) + (v[q].z * v[q].z + v[q].w * v[q].w); }
        const float rstd = 1.f / sqrtf(wave_sum(s2) * (1.f / D) + LN_EPS);
#pragma unroll
        for (int q = 0; q < 4; ++q) orow[64 * q] = v[q] * rstd * gn[q] + bs[q];
    }
}
__device__ __forceinline__ void p2_conv(Frame& F) {
    const size_t gt = (size_t)F.vcu * (NWAVES * 64) + F.tid, NT_ = (size_t)F.G * NWAVES * 64;
    for (size_t it = gt; it < (size_t)M * 128; it += NT_) {
        const size_t m = it >> 7; const int ch = (int)(it & 127) * 8, t = (int)(m & (T - 1));
        const v4u z4 = {0u, 0u, 0u, 0u};
        const v4u w2 = *(const GAS v4u*)(F.Wc + m * D + ch);
        const v4u w1 = t >= 1 ? *(const GAS v4u*)(F.Wc + (m - 1) * D + ch) : z4;
        const v4u w0 = t >= 2 ? *(const GAS v4u*)(F.Wc + (m - 2) * D + ch) : z4;
        const v4u g = *(const GAS v4u*)(F.Gc + m * D + ch);
        const f32x4 c0a = *(const GAS f32x4*)(F.conv_w + ch), c0b = *(const GAS f32x4*)(F.conv_w + ch + 4);
        const f32x4 c1a = *(const GAS f32x4*)(F.conv_w + D + ch), c1b = *(const GAS f32x4*)(F.conv_w + D + ch + 4);
        const f32x4 c2a = *(const GAS f32x4*)(F.conv_w + 2 * D + ch), c2b = *(const GAS f32x4*)(F.conv_w + 2 * D + ch + 4);
#define CV(e, W0, W1, W2, GG, LOHI, CA, CB, CC, idx) (LOHI(GG) * (CA[idx] * LOHI(W0) + CB[idx] * LOHI(W1) + CC[idx] * LOHI(W2)))
        v4u o;
        o.x = pk2(CV(0, w0.x, w1.x, w2.x, g.x, pg8::bf_lo, c0a, c1a, c2a, 0), CV(1, w0.x, w1.x, w2.x, g.x, pg8::bf_hi, c0a, c1a, c2a, 1));
        o.y = pk2(CV(2, w0.y, w1.y, w2.y, g.y, pg8::bf_lo, c0a, c1a, c2a, 2), CV(3, w0.y, w1.y, w2.y, g.y, pg8::bf_hi, c0a, c1a, c2a, 3));
        o.z = pk2(CV(4, w0.z, w1.z, w2.z, g.z, pg8::bf_lo, c0b, c1b, c2b, 0), CV(5, w0.z, w1.z, w2.z, g.z, pg8::bf_hi, c0b, c1b, c2b, 1));
        o.w = pk2(CV(6, w0.w, w1.w, w2.w, g.w, pg8::bf_lo, c0b, c1b, c2b, 2), CV(7, w0.w, w1.w, w2.w, g.w, pg8::bf_hi, c0b, c1b, c2b, 3));
#undef CV
        *(GAS v4u*)(F.Gc + m * D + ch) = o;
    }
}
__device__ __forceinline__ int t5_bucket(int n) {
    if (n < 16) return n;
    const int lg = 16 + (int)(__logf((float)n * (1.0f / 16.0f)) * (16.0f / 2.0794415416798357f));
    return lg < 31 ? lg : 31;
}
__device__ __forceinline__ float diff_lambda(Frame& F) {
    float s1 = 0.f, s2 = 0.f;
    for (int d = 0; d < 64; ++d) { s1 += F.lq1[d] * F.lk1[d]; s2 += F.lq2[d] * F.lk2[d]; }
    return expf(s1) - expf(s2) + 0.2f;
}

#ifdef ATTN_NAIVE
__device__ __forceinline__ void p2_attn_naive(Frame& F) {
    LAS unsigned char* Kt = F.lds + RING_OFF;
    LAS unsigned char* Vt = Kt + 16384;
    LAS float* O1 = (LAS float*)(Kt + 32768);
    LAS float* tbl = (LAS float*)(Kt + 32768 + 128 * 129 * 4);
    LAS float* SSQ = tbl + 128;
    const int tid = F.tid, row = tid & 127, map = __builtin_amdgcn_readfirstlane((tid >> 7) & 1), half = __builtin_amdgcn_readfirstlane(tid >> 8);
    const float lam = diff_lambda(F);
    for (int i = 0; i < 8; ++i) {
        const int bh = F.vcu >> 3, s = F.vcu & 7, qb = (i & 1) ? (16 * (i >> 1) + 15 - s) : (16 * (i >> 1) + s), b = bh >> 3, h = bh & 7;
        __syncthreads();
        if (tid < 128) tbl[tid] = F.rel_bias[t5_bucket(tid) * 8 + h] * 1.4426950408889634f;
        const int qpos = qb * 128 + row; const size_t rowg = (size_t)b * T + qpos;
        float q[64], o[64];
        { const GAS v4u* qp = (const GAS v4u*)(F.Qb + rowg * D + h * 128 + map * 64);
#pragma unroll
          for (int c8 = 0; c8 < 8; ++c8) { const v4u w = qp[c8]; q[c8 * 8 + 0] = pg8::bf_lo(w.x); q[c8 * 8 + 1] = pg8::bf_hi(w.x); q[c8 * 8 + 2] = pg8::bf_lo(w.y); q[c8 * 8 + 3] = pg8::bf_hi(w.y);
              q[c8 * 8 + 4] = pg8::bf_lo(w.z); q[c8 * 8 + 5] = pg8::bf_hi(w.z); q[c8 * 8 + 6] = pg8::bf_lo(w.w); q[c8 * 8 + 7] = pg8::bf_hi(w.w); } }
#pragma unroll
        for (int d = 0; d < 64; ++d) o[d] = 0.f;
        float mx = -1e30f, l = 0.f;
        const int ntile = (qb * 128 + 128) / 64;
        for (int t = 0; t < ntile; ++t) {
            __syncthreads();
            for (int c = tid; c < 1024; c += NWAVES * 64) { const int r = c >> 4, ch = c & 15; const size_t g = ((size_t)b * T + t * 64 + r) * D + h * 128 + ch * 8;
                *(LAS v4u*)(Kt + r * 256 + ch * 16) = *(const GAS v4u*)(F.Kb + g); *(LAS v4u*)(Vt + r * 256 + ch * 16) = *(const GAS v4u*)(F.Vb + g); }
            __syncthreads();
            const int kmax = qpos - t * 64 + 1;
            for (int jk = 0; jk < 64; ++jk) {
                if (jk < kmax) {
                    float sc = 0.f;
#pragma unroll
                    for (int c8 = 0; c8 < 8; ++c8) { const v4u w = *(const LAS v4u*)(Kt + jk * 256 + map * 128 + c8 * 16);
                        sc += q[c8 * 8 + 0] * pg8::bf_lo(w.x) + q[c8 * 8 + 1] * pg8::bf_hi(w.x) + q[c8 * 8 + 2] * pg8::bf_lo(w.y) + q[c8 * 8 + 3] * pg8::bf_hi(w.y)
                            + q[c8 * 8 + 4] * pg8::bf_lo(w.z) + q[c8 * 8 + 5] * pg8::bf_hi(w.z) + q[c8 * 8 + 6] * pg8::bf_lo(w.w) + q[c8 * 8 + 7] * pg8::bf_hi(w.w); }
                    const int dist = qpos - (t * 64 + jk);
                    sc += tbl[dist < 127 ? dist : 127];
                    if (sc > mx) { const float f = __builtin_amdgcn_exp2f(mx - sc); l *= f;
#pragma unroll
                        for (int d = 0; d < 64; ++d) o[d] *= f;
                        mx = sc; }
                    const float p = __builtin_amdgcn_exp2f(sc - mx); l += p;
#pragma unroll
                    for (int c8 = 0; c8 < 8; ++c8) { const v4u w = *(const LAS v4u*)(Vt + jk * 256 + half * 128 + c8 * 16);
                        o[c8 * 8 + 0] += p * pg8::bf_lo(w.x); o[c8 * 8 + 1] += p * pg8::bf_hi(w.x); o[c8 * 8 + 2] += p * pg8::bf_lo(w.y); o[c8 * 8 + 3] += p * pg8::bf_hi(w.y);
                        o[c8 * 8 + 4] += p * pg8::bf_lo(w.z); o[c8 * 8 + 5] += p * pg8::bf_hi(w.z); o[c8 * 8 + 6] += p * pg8::bf_lo(w.w); o[c8 * 8 + 7] += p * pg8::bf_hi(w.w); }
                }
            }
        }
        const float il = 1.0f / l;
        if (map == 1) {
#pragma unroll
            for (int d = 0; d < 64; ++d) O1[row * 129 + half * 64 + d] = o[d] * il; }
        __syncthreads();
        if (map == 0) { float ss = 0.f;
#pragma unroll
            for (int d = 0; d < 64; ++d) { o[d] = o[d] * il - lam * O1[row * 129 + half * 64 + d]; ss += o[d] * o[d]; }
            SSQ[row * 2 + half] = ss; }
        __syncthreads();
        if (map == 0) { const float rn = 1.0f / sqrtf((SSQ[row * 2] + SSQ[row * 2 + 1]) * (1.0f / 128.0f) + RMS_EPS) * 0.8f;
            const size_t ob = rowg * D + h * 128 + half * 64;
#pragma unroll
            for (int c8 = 0; c8 < 8; ++c8) { const v4u z = *(const GAS v4u*)(F.SZ + ob + c8 * 8); const f32x4 g0 = *(const GAS f32x4*)(F.subln + half * 64 + c8 * 8), g1 = *(const GAS f32x4*)(F.subln + half * 64 + c8 * 8 + 4);
                v4u w; w.x = pk2(o[c8 * 8 + 0] * rn * g0.x * pg8::bf_lo(z.x), o[c8 * 8 + 1] * rn * g0.y * pg8::bf_hi(z.x)); w.y = pk2(o[c8 * 8 + 2] * rn * g0.z * pg8::bf_lo(z.y), o[c8 * 8 + 3] * rn * g0.w * pg8::bf_hi(z.y));
                w.z = pk2(o[c8 * 8 + 4] * rn * g1.x * pg8::bf_lo(z.z), o[c8 * 8 + 5] * rn * g1.y * pg8::bf_hi(z.z)); w.w = pk2(o[c8 * 8 + 6] * rn * g1.z * pg8::bf_lo(z.w), o[c8 * 8 + 7] * rn * g1.w * pg8::bf_hi(z.w));
                *(GAS v4u*)(F.YA + ob + c8 * 8) = w; } }
    }
}

#endif
struct Args { const float* in[18]; float* out; unsigned char* ws; int ph_lo, ph_hi, li, pad; };
__global__ void __launch_bounds__(NWAVES * 64, 2) skel_fwd(Args args) {
    extern __shared__ __attribute__((aligned(16))) unsigned char lds[];
    Frame F;
    F.lds = (LAS unsigned char*)lds;
    F.MISC = (volatile LAS unsigned*)(F.lds + MISC_OFF);
    F.tid = threadIdx.x; F.lane = F.tid & 63; F.wave = __builtin_amdgcn_readfirstlane(F.tid >> 6);
    F.G = gridDim.x; { const int bx = blockIdx.x; F.vcu = (F.G % 8 == 0) ? (bx % 8) * (F.G / 8) + bx / 8 : bx; }
    unsigned char* ws = args.ws;
    F.ctl = (gu32*)(ws + WS_CTL);
    F.x = args.in[0]; F.c = args.in[1]; F.w_ada = args.in[2]; F.b_ada = args.in[3]; F.w_in = args.in[4]; F.lq1 = args.in[5]; F.lk1 = args.in[6]; F.lq2 = args.in[7]; F.lk2 = args.in[8];
    F.subln = args.in[9]; F.rel_bias = args.in[10]; F.conv_w = args.in[11]; F.w_branch = args.in[12]; F.w_gate = args.in[13]; F.b_gate = args.in[14]; F.w_out = args.in[15];
    F.ln_gain = args.in[16]; F.ln_bias = args.in[17]; F.out = args.out;
    F.Bt1 = (bf16*)(ws + WS_BT1); F.WB0t = (bf16*)(ws + WS_WB0); F.WB1t = (bf16*)(ws + WS_WB1); F.WOt = (bf16*)(ws + WS_WO);
    F.Qb = (bf16*)(ws + WS_Q); F.Kb = (bf16*)(ws + WS_K); F.Vb = (bf16*)(ws + WS_V); F.SZ = (bf16*)(ws + WS_SZ); F.Wc = (bf16*)(ws + WS_WC); F.Gc = (bf16*)(ws + WS_GC);
    F.U = (bf16*)(ws + WS_U); F.YA = (bf16*)(ws + WS_Q); F.MRG = (bf16*)(ws + WS_SZ); F.GATE = (bf16*)(ws + WS_K); F.PRE = (float*)(ws + WS_K);
    F.modp = (float*)(ws + WS_MODP); F.modr = (float*)(ws + WS_MODR);
    for (int u = F.tid; u < (LDS_BYTES - LDSCTL_OFF) / 4; u += NWAVES * 64) ((LAS unsigned*)(F.lds + LDSCTL_OFF))[u] = 0u;
    __syncthreads();
    XcdBarrier bar = xcd_barrier_post((unsigned*)(F.ctl + CW_BAR) + args.li * XCD_BAR_WORDS, F.MISC + 8);
#define GRID_BAR() xcd_barrier(bar)
    const int lo = args.ph_lo, hi = args.ph_hi;
#define IN(k) (lo <= (k) && (k) < hi)
#define BOTH(k) (IN(k) && IN((k) + 1))

#if DIAG == 3
    { float* scrg = (float*)(ws + 480 * MiB); const size_t gt = (size_t)F.vcu * (NWAVES * 64) + F.tid, NT_ = (size_t)F.G * NWAVES * 64;
      for (size_t i = gt; i < (size_t)2 * 1024 * 1024; i += NT_) scrg[i] = F.w_gate[i]; }
#endif
    if (IN(0)) { p0_prologue(F); if (BOTH(0)) GRID_BAR(); }
    if (IN(1)) { p0b_adaln(F); if (BOTH(1)) GRID_BAR(); }
    if (IN(2)) {
        pg8::Gemm g{F.U, F.Bt1, nullptr, nullptr, M, NPROJ, D}; pg8::StaticOrder S; S.init(M, NPROJ, F.G, (int)blockIdx.x);
        pg8::EpiProj E{F.Qb, (size_t)(WS_K - WS_Q) / 2, F.Wc, F.Gc};
        pg8::gemm_phase<pg8::EpiProj, pg8::StaticOrder, true, true, false>(F.lds + RING_OFF, g, S, E);
        if (BOTH(2)) GRID_BAR();
    }
    if (IN(3)) {
        p2_conv(F);
#ifdef ATTN_NAIVE
        p2_attn_naive(F);
#else
        { const float lam = diff_lambda(F); const int bh = F.vcu >> 3, s = F.vcu & 7;
          for (int i = 0; i < 4; ++i) { const int qb = (i == 0) ? s : (i == 1) ? 15 - s : (i == 2) ? 16 + s : 31 - s;
              attn_body::attn_unit<8>(bh >> 3, bh & 7, qb, (const attn_body::bf16*)F.Qb, (const attn_body::bf16*)F.Kb, (const attn_body::bf16*)F.Vb, (const attn_body::bf16*)F.SZ, (attn_body::bf16*)F.YA,
                                      F.subln, F.rel_bias, lam, (char*)lds + RING_OFF); } }
#endif
        if (BOTH(3)) GRID_BAR();
    }
    if (IN(4)) {
        pg8::Gemm g{F.U, F.Bt1 + (size_t)NPROJ * D, nullptr, nullptr, M, NGATE, D}; pg8::StaticOrder S; S.init(M, NGATE, F.G, (int)blockIdx.x);
        pg8::EpiGate E{F.GATE, F.b_gate};
        pg8::gemm_phase<pg8::EpiGate, pg8::StaticOrder, true, true, false>(F.lds + RING_OFF, g, S, E);
        if (BOTH(4)) GRID_BAR();
    }
    if (IN(5) && DIAG != 1 && DIAG < 3) {
        pg8::Gemm g{F.YA, F.WB0t, F.Gc, F.WB1t, M, D, D}; pg8::DualOrder S; S.base.init(M, D, F.G, (int)blockIdx.x);
        pg8::EpiMerged E{F.GATE, F.MRG};
        pg8::gemm_phase<pg8::EpiMerged, pg8::DualOrder, true, true, true>(F.lds + RING_OFF, g, S, E);
        if (BOTH(5)) GRID_BAR();
    }
    if (IN(6) && DIAG == 0) {
        pg8::Gemm g{F.MRG, F.WOt, nullptr, nullptr, M, D, D}; pg8::StaticOrder S; S.init(M, D, F.G, (int)blockIdx.x);
        pg8::EpiOut E{F.x, F.PRE, F.modr};
        pg8::gemm_phase<pg8::EpiOut, pg8::StaticOrder, true, true, false>(F.lds + RING_OFF, g, S, E);
        if (BOTH(6)) GRID_BAR();
    }
#if DIAG == 1
    if (IN(7)) { const size_t gt = (size_t)F.vcu * (NWAVES * 64) + F.tid, NT_ = (size_t)F.G * NWAVES * 64;
        for (size_t i = gt; i < (size_t)M * D; i += NT_) F.out[i] = __uint_as_float((unsigned)F.GATE[(i >> 10) * 2048 + (i & 1023)] << 16); }
#elif DIAG == 3
    if (IN(7)) { const float* scrg = (const float*)(ws + 480 * MiB); const size_t gt = (size_t)F.vcu * (NWAVES * 64) + F.tid, NT_ = (size_t)F.G * NWAVES * 64;
        for (size_t i = gt; i < (size_t)M * D; i += NT_) F.out[i] = scrg[i & (2 * 1024 * 1024 - 1)]; }
#elif DIAG == 4
    if (IN(7)) { const bf16* src = F.Bt1 + (size_t)NPROJ * D; const size_t gt = (size_t)F.vcu * (NWAVES * 64) + F.tid, NT_ = (size_t)F.G * NWAVES * 64;
        for (size_t i = gt; i < (size_t)M * D; i += NT_) F.out[i] = __uint_as_float((unsigned)src[i & (2 * 1024 * 1024 - 1)] << 16); }
#elif DIAG == 2
    if (IN(7)) { const size_t gt = (size_t)F.vcu * (NWAVES * 64) + F.tid, NT_ = (size_t)F.G * NWAVES * 64;
        for (size_t i = gt; i < (size_t)M * D; i += NT_) F.out[i] = __uint_as_float((unsigned)F.MRG[i] << 16); }
#else
    if (IN(7)) { p5_final_ln(F); }
#endif
#undef IN
#undef BOTH
}

extern "C" void kernel_launch(void* const* d_in, const int* in_sizes, int n_in, void* d_out, int out_size, void* d_ws, size_t ws_size, hipStream_t stream) {
    static int grid = 0;
    if (grid == 0) {
        if (n_in != 18 || in_sizes[0] != M * D || out_size != M * D || ws_size < WS_END) { fprintf(stderr, "kernel_launch: shape/workspace mismatch (n_in %d, in0 %d, out %d, ws %zu); nothing launched\n", n_in, n_in > 0 ? in_sizes[0] : -1, out_size, ws_size); grid = -1; return; }
        int dev = 0, cus = 0, per_cu = 0;
        if (hipGetDevice(&dev) != hipSuccess || hipDeviceGetAttribute(&cus, hipDeviceAttributeMultiprocessorCount, dev) != hipSuccess) { fprintf(stderr, "kernel_launch: hipGetDevice / hipDeviceGetAttribute failed\n"); grid = -1; return; }
        if (hipFuncSetAttribute((const void*)skel_fwd, hipFuncAttributeMaxDynamicSharedMemorySize, LDS_BYTES) != hipSuccess) { fprintf(stderr, "kernel_launch: hipFuncSetAttribute failed\n"); grid = -1; return; }
        if (hipOccupancyMaxActiveBlocksPerMultiprocessor(&per_cu, (const void*)skel_fwd, NWAVES * 64, LDS_BYTES) != hipSuccess || per_cu < 1)
            fprintf(stderr, "kernel_launch: note: the occupancy query reports %d workgroups per CU\n", per_cu);
        (void)hipGetLastError();
        grid = cus;
    }
    if (grid < 0) return;
    if (hipMemsetAsync((char*)d_ws + WS_CTL, 0, CTL_ZERO_BYTES, stream) != hipSuccess) { fprintf(stderr, "kernel_launch: hipMemsetAsync failed\n"); return; }
    Args a{};
    for (int i = 0; i < 18; ++i) a.in[i] = (const float*)d_in[i];
    a.out = (float*)d_out; a.ws = (unsigned char*)d_ws;
    const int NPH = 8;
    const int cuts[N_LAUNCHES + 1] = LAUNCH_CUTS;
    for (int li = 0; li < N_LAUNCHES; ++li) {
        a.ph_lo = cuts[li]; a.ph_hi = cuts[li + 1]; a.li = li; (void)NPH;
        hipLaunchKernelGGL(skel_fwd, dim3(grid), dim3(NWAVES * 64), LDS_BYTES, stream, a);
        const hipError_t le = hipPeekAtLastError();
        if (le != hipSuccess) { fprintf(stderr, "kernel_launch: launch %d failed: %s\n", li, hipGetErrorName(le)); break; }
    }
}
```
